# Optimizing an MI355X kernel written in HIP

```python
import jax, jax.numpy as jnp
from jax import lax
import numpy as np

D_MODEL = 2048
BATCH = 4
SEQ = 2048
DEPTH = 4

EPS = 1e-6
HEAD_DIM = 64
A_HEADS = D_MODEL // (2 * HEAD_DIM)
A_KV_HEADS = A_HEADS // 4
WINDOW = 128
ROPE_THETA = 10000.0
B_GROUP_DIM = 128
B_GROUPS = D_MODEL // (2 * B_GROUP_DIM)
B_CHUNK = 128
A_Q = A_HEADS * HEAD_DIM
A_KV = A_KV_HEADS * HEAD_DIM
B_W = B_GROUPS * B_GROUP_DIM
AB_IN = A_Q + 2 * A_KV + 2 * B_W
AB_MIX = A_Q + B_W
C_KDIM = 128
C_HEADS = D_MODEL // C_KDIM
C_VDIM = D_MODEL // C_HEADS
C_K = C_HEADS * C_KDIM
C_V = C_HEADS * C_VDIM
C_IN = 2 * C_K + 2 * C_V
C_CHUNK = 64
N_GROUPS = 4
EXPERTS_PER_GROUP = 4
N_EXPERTS = N_GROUPS * EXPERTS_PER_GROUP
TOP_K = 2
D_EXPERT = D_MODEL // 4
N_A_LAYERS = (DEPTH + 1) // 2
N_C_LAYERS = DEPTH // 2

kernel_name = "hybrid_swa_gmlp_hgrn2_grouped_moe"

F32 = jnp.float32


def rms_norm(x, g):
    xf = x.astype(F32)
    y = xf * lax.rsqrt(jnp.mean(xf * xf, axis=-1, keepdims=True) + EPS)
    return (y * g.astype(F32)).astype(x.dtype)


def layer_norm_gain(x, g):
    xf = x.astype(F32)
    mu = jnp.mean(xf, axis=-1, keepdims=True)
    xc = xf - mu
    y = xc * lax.rsqrt(jnp.mean(xc * xc, axis=-1, keepdims=True) + EPS)
    return (y * g.astype(F32)).astype(x.dtype)


def modulate(h, shift, scale):
    return h * (1 + scale[:, None, :]) + shift[:, None, :]


def rope(x, positions):
    half = x.shape[-1] // 2
    inv_freq = ROPE_THETA ** (-jnp.arange(half, dtype=F32) / half)
    ang = positions.astype(F32)[..., None] * inv_freq
    cos = jnp.cos(ang)[:, :, None, :]
    sin = jnp.sin(ang)[:, :, None, :]
    xf = x.astype(F32)
    x1, x2 = xf[..., :half], xf[..., half:]
    out = jnp.concatenate([x1 * cos - x2 * sin, x2 * cos + x1 * sin], axis=-1)
    return out.astype(x.dtype)


def sliding_window_attention(q, k, v, sinks):
    bsz, s_len, n_h, hd = q.shape
    nb = s_len // WINDOW
    rep = n_h // A_KV_HEADS
    qb = q.reshape(bsz, nb, WINDOW, A_KV_HEADS, rep, hd)

    def band(t):
        tb = t.reshape(bsz, nb, WINDOW, A_KV_HEADS, hd)
        prev = jnp.pad(tb, ((0, 0), (1, 0), (0, 0), (0, 0), (0, 0)))[:, :-1]
        return jnp.concatenate([prev, tb], axis=2)

    kb, vb = band(k), band(v)
    s = jnp.einsum('bnqgrd,bnkgd->bngrqk', qb, kb).astype(F32) * (hd ** -0.5)
    qi = jnp.arange(WINDOW)[:, None]
    kj = jnp.arange(2 * WINDOW)[None, :]
    diff = qi + WINDOW - kj
    band_mask = (diff >= 0) & (diff < WINDOW)
    key_pos = jnp.arange(nb)[:, None] * WINDOW + jnp.arange(2 * WINDOW)[None, :] - WINDOW
    mask = band_mask[None] & (key_pos >= 0)[:, None, :]
    s = jnp.where(mask[None, :, None, None], s, -jnp.inf)
    sink = sinks.astype(F32).reshape(A_KV_HEADS, rep)[None, None, :, :, None, None]
    m = jnp.maximum(jnp.max(s, axis=-1, keepdims=True), sink)
    p = jnp.exp(s - m)
    p = (p / (jnp.sum(p, axis=-1, keepdims=True) + jnp.exp(sink - m))).astype(v.dtype)
    o = jnp.einsum('bngrqk,bnkgd->bnqgrd', p, vb)
    return o.reshape(bsz, s_len, n_h * hd)


def chunked_spatial_gating(u, v, vnorm_g, w_s, b_s):
    bsz, s_len, _ = v.shape
    nc = s_len // B_CHUNK
    vn = layer_norm_gain(v, vnorm_g).reshape(bsz, nc, B_CHUNK, B_GROUPS, B_GROUP_DIM)
    causal = jnp.tril(jnp.ones((B_CHUNK, B_CHUNK), dtype=bool))
    w = jnp.where(causal[None], w_s, jnp.zeros_like(w_s))
    sv = jnp.einsum('gts,bnsgd->bntgd', w, vn) + b_s.T[None, None, :, :, None]
    return u * sv.reshape(bsz, s_len, B_W)


def hgrn2_chunkwise(q, f_logit, inp, lb):
    bsz, s_len, _ = q.shape
    nc = s_len // C_CHUNK
    lbf = lb.astype(F32)
    f = lbf + (1 - lbf) * jax.nn.sigmoid(f_logit.astype(F32))
    k = 1 - f
    logf = jnp.log(f)

    def to_chunks(t, d):
        return t.astype(F32).reshape(bsz, nc, C_CHUNK, C_HEADS, d).transpose(1, 0, 3, 2, 4)

    qc, kc, lfc = to_chunks(q, C_KDIM), to_chunks(k, C_KDIM), to_chunks(logf, C_KDIM)
    vc = to_chunks(inp, C_VDIM)
    causal = jnp.tril(jnp.ones((C_CHUNK, C_CHUNK), dtype=bool))[:, :, None]

    def step(state, chunk):
        qh, kh, lf, vh = chunk
        b = jnp.cumsum(lf, axis=2)
        o_inter = jnp.einsum('bhtk,bhkv->bhtv', qh * jnp.exp(b), state)
        rel = b[:, :, :, None, :] - b[:, :, None, :, :]
        decay = jnp.exp(jnp.where(causal, rel, -jnp.inf))
        scores = jnp.einsum('bhtsk,bhsk->bhts', qh[:, :, :, None, :] * decay, kh)
        o = o_inter + jnp.einsum('bhts,bhsv->bhtv', scores, vh)
        b_last = b[:, :, -1:, :]
        new_state = jnp.exp(b_last[:, :, 0, :])[..., None] * state + \
            jnp.einsum('bhsk,bhsv->bhkv', kh * jnp.exp(b_last - b), vh)
        return new_state, o

    s0 = jnp.zeros((bsz, C_HEADS, C_KDIM, C_VDIM), F32)
    _, o = lax.scan(step, s0, (qc, kc, lfc, vc))
    return o.transpose(1, 0, 3, 2, 4).reshape(bsz, s_len, C_HEADS, C_VDIM)


def grouped_moe(h, router_w, router_bias, w_gate, w_up, w_down):
    bsz, s_len, d = h.shape
    t = h.reshape(-1, d)
    n_tok = t.shape[0]
    scores = jax.nn.sigmoid(jnp.dot(t, router_w).astype(F32))
    sel = scores + router_bias.astype(F32)
    grp_top = lax.top_k(sel.reshape(n_tok, N_GROUPS, EXPERTS_PER_GROUP), TOP_K)[0]
    _, g_idx = lax.top_k(jnp.sum(grp_top, axis=-1), 1)
    gmask = jnp.repeat(jax.nn.one_hot(g_idx[:, 0], N_GROUPS, dtype=F32), EXPERTS_PER_GROUP, axis=1) > 0
    _, e_idx = lax.top_k(jnp.where(gmask, sel, -jnp.inf), TOP_K)
    w_sel = jnp.take_along_axis(scores, e_idx, axis=1)
    w_sel = w_sel / jnp.sum(w_sel, axis=-1, keepdims=True)
    gates = jnp.sum(jax.nn.one_hot(e_idx, N_EXPERTS, dtype=F32) * w_sel[..., None], axis=1)
    a = jnp.einsum('td,edf->tef', t, w_gate)
    u = jnp.einsum('td,edf->tef', t, w_up)
    hid = jax.nn.silu(a) * u * gates[..., None].astype(t.dtype)
    y = jnp.einsum('tef,efd->td', hid, w_down)
    return y.reshape(bsz, s_len, d)


def setup_inputs(seed: int = 0) -> dict:
    key = jax.random.key(seed)
    ks = iter(jax.random.split(key, 32))

    def nrm(shape, scale):
        return jax.random.normal(next(ks), shape, F32) * scale

    x = nrm((BATCH, SEQ, D_MODEL), 1.0)
    c = nrm((BATCH, D_MODEL), 1.0)
    start = jax.random.randint(next(ks), (BATCH, 1), 0, 4096, dtype=jnp.int32)
    positions = start + jnp.arange(SEQ, dtype=jnp.int32)[None, :]
    return {
        "x": x,
        "c": c,
        "positions": positions,
        "ada_w": nrm((DEPTH, D_MODEL, 6 * D_MODEL), 0.5 * D_MODEL ** -0.5),
        "ada_b": nrm((DEPTH, 6 * D_MODEL), 0.02),
        "norm1_g": 1.0 + nrm((DEPTH, D_MODEL), 0.05),
        "norm2_g": 1.0 + nrm((DEPTH, D_MODEL), 0.05),
        "ab_w_in": nrm((N_A_LAYERS, D_MODEL, AB_IN), D_MODEL ** -0.5),
        "q_norm_g": 1.0 + nrm((N_A_LAYERS, HEAD_DIM), 0.05),
        "k_norm_g": 1.0 + nrm((N_A_LAYERS, HEAD_DIM), 0.05),
        "sinks": nrm((N_A_LAYERS, A_HEADS), 1.0),
        "gm_vnorm_g": 1.0 + nrm((N_A_LAYERS, B_W), 0.05),
        "gm_ws": nrm((N_A_LAYERS, B_GROUPS, B_CHUNK, B_CHUNK), B_CHUNK ** -0.5),
        "gm_b": 1.0 + nrm((N_A_LAYERS, B_GROUPS, B_CHUNK), 0.1),
        "ab_w_out": nrm((N_A_LAYERS, AB_MIX, D_MODEL), AB_MIX ** -0.5),
        "c_w_in": nrm((N_C_LAYERS, D_MODEL, C_IN), D_MODEL ** -0.5),
        "c_lower_bounds": nrm((DEPTH, C_K), 0.1),
        "c_onorm_g": 1.0 + nrm((N_C_LAYERS, C_VDIM), 0.05),
        "c_w_out": nrm((N_C_LAYERS, C_V, D_MODEL), C_V ** -0.5),
        "router_w": nrm((D_MODEL, N_EXPERTS), D_MODEL ** -0.5),
        "router_bias": nrm((N_EXPERTS,), 0.01),
        "moe_w_gate": nrm((DEPTH, N_EXPERTS, D_MODEL, D_EXPERT), D_MODEL ** -0.5),
        "moe_w_up": nrm((DEPTH, N_EXPERTS, D_MODEL, D_EXPERT), D_MODEL ** -0.5),
        "moe_w_down": nrm((DEPTH, N_EXPERTS, D_EXPERT, D_MODEL), D_EXPERT ** -0.5),
    }


def reference(x, c, positions, ada_w, ada_b, norm1_g, norm2_g, ab_w_in, q_norm_g, k_norm_g,
              sinks, gm_vnorm_g, gm_ws, gm_b, ab_w_out, c_w_in, c_lower_bounds, c_onorm_g,
              c_w_out, router_w, router_bias, moe_w_gate, moe_w_up, moe_w_down):
    bsz, s_len, _ = x.shape
    sm = jax.nn.softmax(c_lower_bounds.astype(F32), axis=0)
    lower_bounds = jnp.cumsum(sm, axis=0) - sm[0:1]
    cond = jax.nn.silu(c)
    for l in range(DEPTH):
        mod = jnp.dot(cond, ada_w[l]) + ada_b[l]
        sh1, sc1, g1, sh2, sc2, g2 = jnp.split(mod, 6, axis=-1)
        h = modulate(rms_norm(x, norm1_g[l]), sh1, sc1)
        if l % 2 == 0:
            i = l // 2
            proj = jnp.dot(h, ab_w_in[i])
            q, k, v, u_b, v_b = jnp.split(
                proj, [A_Q, A_Q + A_KV, A_Q + 2 * A_KV, A_Q + 2 * A_KV + B_W], axis=-1)
            q = q.reshape(bsz, s_len, A_HEADS, HEAD_DIM)
            k = k.reshape(bsz, s_len, A_KV_HEADS, HEAD_DIM)
            v = v.reshape(bsz, s_len, A_KV_HEADS, HEAD_DIM)
            q = rope(rms_norm(q, q_norm_g[i]), positions)
            k = rope(rms_norm(k, k_norm_g[i]), positions)
            o_a = sliding_window_attention(q, k, v, sinks[i])
            o_b = chunked_spatial_gating(jax.nn.gelu(u_b), jax.nn.gelu(v_b),
                                         gm_vnorm_g[i], gm_ws[i], gm_b[i])
            y = jnp.dot(jnp.concatenate([o_a, o_b], axis=-1), ab_w_out[i])
        else:
            j = l // 2
            proj = jnp.dot(h, c_w_in[j])
            q, f_logit, inp, gate = jnp.split(proj, [C_K, 2 * C_K, 2 * C_K + C_V], axis=-1)
            o = hgrn2_chunkwise(q, f_logit, inp, lower_bounds[l]).astype(h.dtype)
            o = rms_norm(o, c_onorm_g[j]) * jax.nn.silu(gate.reshape(bsz, s_len, C_HEADS, C_VDIM))
            y = jnp.dot(o.reshape(bsz, s_len, C_V), c_w_out[j])
        x = x + g1[:, None, :] * y
        h = modulate(rms_norm(x, norm2_g[l]), sh2, sc2)
        x = x + g2[:, None, :] * grouped_moe(h, router_w, router_bias,
                                             moe_w_gate[l], moe_w_up[l], moe_w_down[l])
    return x
```

```cpp
#include <hip/hip_runtime.h>
#include <cstdio>
#include <cstdint>


#ifndef PROBE_DUP
#define PROBE_DUP 0
#endif
#define LAS __attribute__((address_space(3)))
#define GAS __attribute__((address_space(1)))
typedef unsigned short bf16_t;
typedef short bf16x8 __attribute__((ext_vector_type(8)));
typedef float f32x4 __attribute__((ext_vector_type(4)));
typedef float f32x2 __attribute__((ext_vector_type(2)));
typedef unsigned u32x4 __attribute__((ext_vector_type(4)));
typedef unsigned u32x2 __attribute__((ext_vector_type(2)));

constexpr int D = 2048, NBATCH = 4, SEQ = 2048, T = NBATCH * SEQ, DEPTH = 4;
constexpr int ABIN = 3584, CIN = 8192, NE = 16, DE = 512;
constexpr float EPS = 1e-6f;

constexpr size_t MiB = 1u << 20;
constexpr size_t WS_CTL = 0, CTL_ZERO_BYTES = 1 * MiB;
constexpr size_t WS_MOD = 1 * MiB;
constexpr size_t WS_LB = 2 * MiB;
constexpr size_t WS_WABIN = 4 * MiB;
constexpr size_t WS_WABOUT = WS_WABIN + 28 * MiB;
constexpr size_t WS_WCIN = WS_WABOUT + 16 * MiB;
constexpr size_t WS_WCOUT = WS_WCIN + 64 * MiB;
constexpr size_t WS_WGU = WS_WCOUT + 16 * MiB;
constexpr size_t WS_WDN = WS_WGU + 256 * MiB;
constexpr size_t WS_H = WS_WDN + 128 * MiB;
constexpr size_t WS_PROJ = WS_H + 32 * MiB;
constexpr size_t WS_LOGF = WS_PROJ + 128 * MiB;
constexpr size_t WS_MIX = WS_LOGF + 64 * MiB;
constexpr size_t WS_MOE = WS_MIX + 32 * MiB;
constexpr size_t WS_LIST = WS_MOE, WS_GW = WS_MOE + 512 * 1024, WS_TOKINFO = WS_MOE + 1024 * 1024;
constexpr size_t WS_HID = WS_MOE + 2 * MiB;
constexpr size_t WS_Y = WS_HID + 20 * MiB;
constexpr size_t WS_ASORT = WS_Y + 80 * MiB;
constexpr size_t WS_STATS = WS_ASORT + 512 * MiB;
constexpr size_t WS_HGL = WS_STATS + 1 * MiB;
constexpr size_t WS_HGD = WS_HGL + 12 * MiB;
constexpr size_t WS_END = WS_HGD + 1 * MiB;
constexpr int CW_BAR = 4096;
constexpr int CW_QHEAD = 12288;
constexpr int CW_CNT = 16384;

constexpr int LDS_BYTES = 147456;
constexpr int MISC_OFF = LDS_BYTES - 1024;

typedef __bf16 bf16x2_t __attribute__((ext_vector_type(2)));
__device__ __forceinline__ unsigned cvt_pk_bf16(float lo, float hi) { return __builtin_bit_cast(unsigned, __builtin_convertvector((f32x2){lo, hi}, bf16x2_t)); }
__device__ __forceinline__ float bf_lo(unsigned w) { return __uint_as_float(w << 16); }
__device__ __forceinline__ float bf_hi(unsigned w) { return __uint_as_float(w & 0xffff0000u); }
__device__ __forceinline__ float bf2f(bf16_t b) { return __uint_as_float(((unsigned)b) << 16); }
__device__ __forceinline__ bf16_t f2bf(float f) { return (bf16_t)(cvt_pk_bf16(f, 0.f) & 0xffffu); }
template <int O> __device__ __forceinline__ float sx(float v) { static_assert(O > 0 && O < 32, "ds_swizzle xor within 32 lanes"); return __int_as_float(__builtin_amdgcn_ds_swizzle(__float_as_int(v), (O << 10) | 0x1f)); }
__device__ __forceinline__ float sum_x32(float v) { const unsigned x = (unsigned)__float_as_int(v); const auto r = __builtin_amdgcn_permlane32_swap(x, x, false, false); return __int_as_float((int)r[0]) + __int_as_float((int)r[1]); }
__device__ __forceinline__ float get_x32(float v, bool upper) { const unsigned x = (unsigned)__float_as_int(v); const auto r = __builtin_amdgcn_permlane32_swap(x, x, false, false); return __int_as_float((int)(upper ? r[0] : r[1])); }
__device__ __forceinline__ float wave_sum(float v) { v += sx<1>(v); v += sx<2>(v); v += sx<4>(v); v += sx<8>(v); v += sx<16>(v); return sum_x32(v); }
__device__ __forceinline__ float fast_exp(float x) { return __builtin_amdgcn_exp2f(x * 1.4426950408889634f); }
__device__ __forceinline__ float sigmoidf_(float x) { return __builtin_amdgcn_rcpf(1.0f + fast_exp(-x)); }
__device__ __forceinline__ float gelu_tanh(float x) { const float z = 1.5957691216057308f * (x + 0.044715f * x * x * x); return x * sigmoidf_(z); }

#define XB_TMO      128
#define XB_XCNT(j)  (256  + 64 * (j))
#define XB_XSUB(j)  (1280 + 64 * (j))
#define XB_XGEN(j)  (2304 + 64 * (j))
#define XB_TOP      3328
#define XB_TOPGEN   3392
#define XCD_BAR_WORDS 3456
#define XB_SPIN_CAP (1u << 18)
__device__ __forceinline__ unsigned xb_ld(unsigned* p)              { return __hip_atomic_load(p, __ATOMIC_RELAXED, __HIP_MEMORY_SCOPE_AGENT); }
__device__ __forceinline__ unsigned xb_add(unsigned* p, unsigned v) { return __hip_atomic_fetch_add(p, v, __ATOMIC_RELAXED, __HIP_MEMORY_SCOPE_AGENT); }
__device__ __forceinline__ unsigned xb_xcc_id() { return (unsigned)__builtin_amdgcn_s_getreg((3 << 11) | 20) & 0xFu; }
#define XB_SPIN(cond, bar) do { unsigned _sp = 0; while (cond) { __builtin_amdgcn_s_sleep(1); \
    if ((++_sp & 255u) == 0u) { if (xb_ld(&(bar)[XB_TMO])) break; if (_sp > XB_SPIN_CAP) { atomicAdd(&(bar)[XB_TMO], 1u); break; } } } } while (0)
struct XcdBarrier { unsigned* bar; unsigned x; volatile LAS unsigned* st; };
__device__ __forceinline__ int my_lane() { int l; asm volatile("v_mbcnt_lo_u32_b32 %0, -1, 0\n\tv_mbcnt_hi_u32_b32 %0, -1, %0" : "=v"(l)); return l; }
__device__ __forceinline__ XcdBarrier xcd_barrier_post(unsigned* bar, volatile LAS unsigned* st, int wave) {
    XcdBarrier b; b.bar = bar; b.x = xb_xcc_id(); b.st = st;
    if (wave == 0 && my_lane() == 0) (void)xb_add(&bar[XB_XCNT(b.x)], 1u);
    return b;
}
__device__ __forceinline__ void xcd_barrier_complete(unsigned* bar, unsigned x, unsigned& nloc, unsigned& nx) {
    const unsigned G = gridDim.x * gridDim.y * gridDim.z;
    unsigned sum, cnt, mine, sp = 0u;
    for (;;) {
        sum = 0u; cnt = 0u; mine = 0u;
#pragma unroll
        for (unsigned j = 0; j < 16; ++j) { const unsigned c = xb_ld(&bar[XB_XCNT(j)]); sum += c; cnt += (c > 0u) ? 1u : 0u; mine = (j == x) ? c : mine; }
        if (sum == G) break;
        __builtin_amdgcn_s_sleep(1);
        if ((++sp & 255u) == 0u) { if (xb_ld(&bar[XB_TMO])) break; if (sp > XB_SPIN_CAP) { atomicAdd(&bar[XB_TMO], 1u); break; } }
    }
    nloc = mine > 0u ? mine : 1u; nx = cnt > 0u ? cnt : 1u;
}
__device__ __forceinline__ void xcd_barrier(const XcdBarrier& b, int wave) {
    asm volatile("s_waitcnt vmcnt(0)" ::: "memory");
    __syncthreads();
    if (wave == 0 && my_lane() == 0) {
        unsigned* bar = b.bar;
        __builtin_amdgcn_s_waitcnt(0);
        unsigned nloc = b.st[0], nx = b.st[1];
        if (nloc == 0u) { xcd_barrier_complete(bar, b.x, nloc, nx); b.st[0] = nloc; b.st[1] = nx; }
        const unsigned old = xb_add(&bar[XB_XSUB(b.x)], 1u);
        const unsigned gen = old / nloc;
        if (old + 1u == (gen + 1u) * nloc) {
            __builtin_amdgcn_fence(__ATOMIC_RELEASE, "agent");
            asm volatile("s_waitcnt vmcnt(0)" ::: "memory");
            const unsigned og = xb_add(&bar[XB_TOP], 1u);
            const unsigned tg = og / nx;
            if (og + 1u == (tg + 1u) * nx) xb_add(&bar[XB_TOPGEN], 1u);
            else XB_SPIN(xb_ld(&bar[XB_TOPGEN]) == tg, bar);
            __builtin_amdgcn_fence(__ATOMIC_ACQUIRE, "agent");
            xb_add(&bar[XB_XGEN(b.x)], 1u);
            asm volatile("s_waitcnt vmcnt(0)" ::: "memory");
        } else {
            XB_SPIN(xb_ld(&bar[XB_XGEN(b.x)]) == gen, bar);
            __builtin_amdgcn_fence(__ATOMIC_ACQUIRE, "agent");
            asm volatile("s_waitcnt vmcnt(0)" ::: "memory");
        }
    }
    __syncthreads();
}

namespace pg8 {
constexpr int BM = 256, BK = 64, HALF = 128, HTB = HALF * BK * 2, STAGE_BYTES = 8 * HTB, NXCD = 8, WGM = 4;
__host__ __device__ __forceinline__ int lds_byte(int r, int c) { const int st = (r >> 4) * 2 + (c >> 5), rr = r & 15, cc = c & 31, ob = rr * 64 + cc * 2; return st * 1024 + (ob ^ (((ob >> 9) & 1) << 5)); }
__host__ __device__ __forceinline__ void stage_rc(int b, int& R, int& C) { const int st = b / 1024, sb = b % 1024, swz = sb ^ (((sb >> 9) & 1) << 5); R = (st >> 1) * 16 + swz / 64; C = (st & 1) * 32 + (swz % 64) / 2; }
__host__ __device__ __forceinline__ int perm32(int rho) { const int n = rho >> 4, i = rho & 15; return 8 * (i >> 2) + 4 * n + (i & 3); }

struct Unit { int pm, pn, orow, ocol, aux, nvalid; };
struct Gemm { const bf16_t* A; const bf16_t* Bt; int M, N, K; };

struct StaticOrder {
    int nM, nN, nwg, G, c;
    __device__ void init(int M, int N, int G_, int c_) { nM = M / BM; nN = N / BM; nwg = nM * nN; G = G_; c = c_; }
    __device__ bool next(int i, Unit& u) const {
        const long L = (long)i * G + c; if (L >= nwg) return false;
        int wgid = (int)L; { const int q = nwg / NXCD, r = nwg % NXCD, xcd = wgid % NXCD, off = wgid / NXCD; wgid = (xcd < r ? xcd * (q + 1) : r * (q + 1) + (xcd - r) * q) + off; }
        const int nig = WGM * nN, gid = wgid / nig, fm = gid * WGM, gsz = (nM - fm) < WGM ? (nM - fm) : WGM;
        u.pm = fm + ((wgid % nig) % gsz); u.pn = (wgid % nig) / gsz; u.orow = u.pm * BM; u.ocol = u.pn * BM; u.aux = 0; u.nvalid = 256; return true;
    }
};
struct MoeOrder {
    const LAS int* pb; int NJ, G, c, tbase, colw, acap;
    __device__ bool next(int i, Unit& u) const {
        const int L = i * G + c; const int P = L / NJ, j = L - P * NJ; const int NP = pb[16]; if (P >= NP) return false;
        int e = 0;
#pragma unroll
        for (int k = 1; k < 16; ++k) e += (P >= pb[k]) ? 1 : 0;
        const int p = P - pb[e];
        u.pm = __builtin_amdgcn_readfirstlane(acap ? e * acap + p : P); u.pn = __builtin_amdgcn_readfirstlane(tbase + e * NJ + j); u.orow = __builtin_amdgcn_readfirstlane(P * 256); u.ocol = __builtin_amdgcn_readfirstlane(j * colw);
        u.aux = __builtin_amdgcn_readfirstlane(e * 8192 + p * 256); u.nvalid = __builtin_amdgcn_readfirstlane(pb[17 + e] - p * 256); return true;
    }
};

struct EpiProjA {
    static constexpr bool PERM = true, AFTER_DRAIN = false;
    bf16_t* O; float* STATS;
    __device__ __forceinline__ void operator()(const f32x4 (&acc)[2][2][4][2], const Unit& u, int wr, int wc, int fr, int fq) const {
        const int row0 = u.orow + wr * 64 + fr, col0 = u.ocol + wc * 32 + 8 * fq; const bool act = u.ocol >= 1536, st = u.ocol >= 2560;
#pragma unroll
        for (int ai = 0; ai < 2; ++ai)
#pragma unroll
            for (int m = 0; m < 4; ++m) { bf16_t* rowp = O + (size_t)(row0 + ai * HALF + m * 16) * ABIN + col0; float s1 = 0.f, s2 = 0.f;
#pragma unroll
                for (int bj = 0; bj < 2; ++bj) { f32x4 v0 = acc[ai][bj][m][0], v1 = acc[ai][bj][m][1];
                    if (act) {
#pragma unroll
                        for (int q = 0; q < 4; ++q) { v0[q] = gelu_tanh(v0[q]); v1[q] = gelu_tanh(v1[q]); } }
                    u32x4 w; w.x = cvt_pk_bf16(v0[0], v0[1]); w.y = cvt_pk_bf16(v0[2], v0[3]); w.z = cvt_pk_bf16(v1[0], v1[1]); w.w = cvt_pk_bf16(v1[2], v1[3]);
                    *(u32x4*)(rowp + bj * HALF) = w;
                    if (st) { const float a0 = bf_lo(w.x), a1 = bf_hi(w.x), a2 = bf_lo(w.y), a3 = bf_hi(w.y), a4 = bf_lo(w.z), a5 = bf_hi(w.z), a6 = bf_lo(w.w), a7 = bf_hi(w.w);
                        s1 += ((a0 + a1) + (a2 + a3)) + ((a4 + a5) + (a6 + a7)); s2 += ((a0 * a0 + a1 * a1) + (a2 * a2 + a3 * a3)) + ((a4 * a4 + a5 * a5) + (a6 * a6 + a7 * a7)); } }
                if (st) { s1 += sx<16>(s1); s1 = sum_x32(s1); s2 += sx<16>(s2); s2 = sum_x32(s2);
                    if (fq == 0) *(f32x2*)(STATS + ((size_t)(row0 + ai * HALF + m * 16) * 16 + ((u.ocol - 2560) >> 8) * 4 + wc) * 2) = (f32x2){s1, s2}; } }
    }
};
struct EpiProjC {
    static constexpr bool PERM = true, AFTER_DRAIN = false;
    bf16_t* O; float* LOGF; const float* lb;
    __device__ __forceinline__ void operator()(const f32x4 (&acc)[2][2][4][2], const Unit& u, int wr, int wc, int fr, int fq) const {
        const int row0 = u.orow + wr * 64 + fr, col0 = u.ocol + wc * 32 + 8 * fq; const int mode = u.ocol >> 11;
        if (mode == 1) {
#pragma unroll
            for (int bj = 0; bj < 2; ++bj) { const int k0 = col0 - 2048 + bj * HALF; const f32x4 l0 = *(const f32x4*)(lb + k0), l1 = *(const f32x4*)(lb + k0 + 4);
#pragma unroll
                for (int ai = 0; ai < 2; ++ai)
#pragma unroll
                    for (int m = 0; m < 4; ++m) { float* rowp = LOGF + (size_t)(row0 + ai * HALF + m * 16) * 2048 + k0; f32x4 v0 = acc[ai][bj][m][0], v1 = acc[ai][bj][m][1];
#pragma unroll
                        for (int q = 0; q < 4; ++q) { v0[q] = __logf(l0[q] + (1.0f - l0[q]) * sigmoidf_(v0[q])); v1[q] = __logf(l1[q] + (1.0f - l1[q]) * sigmoidf_(v1[q])); }
                        *(f32x4*)rowp = v0; *(f32x4*)(rowp + 4) = v1; } }
        } else {
#pragma unroll
            for (int ai = 0; ai < 2; ++ai)
#pragma unroll
                for (int m = 0; m < 4; ++m) { bf16_t* rowp = O + (size_t)(row0 + ai * HALF + m * 16) * CIN + col0;
#pragma unroll
                    for (int bj = 0; bj < 2; ++bj) { f32x4 v0 = acc[ai][bj][m][0], v1 = acc[ai][bj][m][1];
                        if (mode == 3) {
#pragma unroll
                            for (int q = 0; q < 4; ++q) { v0[q] = v0[q] * sigmoidf_(v0[q]); v1[q] = v1[q] * sigmoidf_(v1[q]); } }
                        u32x4 w; w.x = cvt_pk_bf16(v0[0], v0[1]); w.y = cvt_pk_bf16(v0[2], v0[3]); w.z = cvt_pk_bf16(v1[0], v1[1]); w.w = cvt_pk_bf16(v1[2], v1[3]);
                        *(u32x4*)(rowp + bj * HALF) = w; } }
        }
    }
};
struct EpiResid {
    static constexpr bool PERM = false, AFTER_DRAIN = false;
    float* X; const float* gate; long wofs;
    __device__ __forceinline__ void operator()(const f32x4 (&acc)[2][2][4][2], const Unit& u, int wr, int wc, int fr, int fq) const {
        const int row0 = u.orow + wr * 64 + fr, col0 = u.ocol + wc * 32 + 4 * fq; const int b = u.orow >> 11;
        f32x4 gv[2][2];
#pragma unroll
        for (int bj = 0; bj < 2; ++bj)
#pragma unroll
            for (int n = 0; n < 2; ++n) gv[bj][n] = *(const f32x4*)(gate + (size_t)b * 12288 + col0 + bj * HALF + n * 16);
#pragma unroll
        for (int ai = 0; ai < 2; ++ai)
#pragma unroll
            for (int m = 0; m < 4; ++m) { float* rowp = X + (size_t)(row0 + ai * HALF + m * 16) * D + col0;
#pragma unroll
                for (int bj = 0; bj < 2; ++bj)
#pragma unroll
                    for (int n = 0; n < 2; ++n) { f32x4* p = (f32x4*)(rowp + bj * HALF + n * 16); *(f32x4*)((float*)p + wofs) = *p + gv[bj][n] * acc[ai][bj][m][n]; } }
    }
};
struct EpiMoe1 {
    static constexpr bool PERM = true, AFTER_DRAIN = false;
    bf16_t* HID; const float* GW;
    __device__ __forceinline__ void operator()(const f32x4 (&acc)[2][2][4][2], const Unit& u, int wr, int wc, int fr, int fq) const {
        const int col0 = u.ocol + wc * 32 + 8 * fq;
#pragma unroll
        for (int ai = 0; ai < 2; ++ai)
#pragma unroll
            for (int m = 0; m < 4; ++m) { const int r = ai * HALF + wr * 64 + m * 16 + fr; const float gw = (r < u.nvalid) ? GW[u.aux + r] : 0.f;
                f32x4 a0 = acc[ai][0][m][0], a1 = acc[ai][0][m][1]; const f32x4 u0 = acc[ai][1][m][0], u1 = acc[ai][1][m][1];
#pragma unroll
                for (int q = 0; q < 4; ++q) { a0[q] = a0[q] * sigmoidf_(a0[q]) * u0[q] * gw; a1[q] = a1[q] * sigmoidf_(a1[q]) * u1[q] * gw; }
                u32x4 w; w.x = cvt_pk_bf16(a0[0], a0[1]); w.y = cvt_pk_bf16(a0[2], a0[3]); w.z = cvt_pk_bf16(a1[0], a1[1]); w.w = cvt_pk_bf16(a1[2], a1[3]);
                *(u32x4*)(HID + (size_t)(u.orow + r) * DE + col0) = w; }
    }
};
struct EpiMoe2 {
    static constexpr bool PERM = true, AFTER_DRAIN = false;
    bf16_t* Y;
    __device__ __forceinline__ void operator()(const f32x4 (&acc)[2][2][4][2], const Unit& u, int wr, int wc, int fr, int fq) const {
        const int row0 = u.orow + wr * 64 + fr, col0 = u.ocol + wc * 32 + 8 * fq;
#pragma unroll
        for (int ai = 0; ai < 2; ++ai)
#pragma unroll
            for (int m = 0; m < 4; ++m) { bf16_t* rowp = Y + (size_t)(row0 + ai * HALF + m * 16) * D + col0;
#pragma unroll
                for (int bj = 0; bj < 2; ++bj) { const f32x4 v0 = acc[ai][bj][m][0], v1 = acc[ai][bj][m][1];
                    u32x4 w; w.x = cvt_pk_bf16(v0[0], v0[1]); w.y = cvt_pk_bf16(v0[2], v0[3]); w.z = cvt_pk_bf16(v1[0], v1[1]); w.w = cvt_pk_bf16(v1[2], v1[3]);
                    *(u32x4*)(rowp + bj * HALF) = w; } }
    }
};

template <class Epi, class Sched, bool ALIGN_EPI = true, bool SP2 = true>
__device__ __forceinline__ void gemm_phase(LAS unsigned char* lds, const Gemm g, const Sched& S, const Epi& E, const int tid) {
    const int wid = __builtin_amdgcn_readfirstlane(tid >> 6), lane = tid & 63, wr = wid >> 2, wc = wid & 3, fr = lane & 15, fq = lane >> 4;
    const int K = g.K, nt = K / BK;
    unsigned voffA[2], voffB[2];
#pragma unroll
    for (int i = 0; i < 2; ++i) { int R, C; stage_rc(tid * 16 + i * 8192, R, C); const int Rb = Epi::PERM ? ((R & ~31) + perm32(R & 31)) : R;
        voffA[i] = (unsigned)(R * K + C) * 2u; voffB[i] = (unsigned)(Rb * K + C) * 2u; }
    const size_t kstep = (size_t)(BK * 2);
    const size_t hstep = (size_t)HALF * K * 2;
    const size_t tstep = 2 * hstep;
    const unsigned ldsw = (unsigned)wid * 1024u;
    const int aoff = lds_byte(wr * 64 + fr, fq * 8), boff = lds_byte(wc * 32 + fr, fq * 8);
#define PG8_SA(b, h) (((b) * 2 + (h)) * HTB)
#define PG8_SB(b, h) ((4 + (b) * 2 + (h)) * HTB)
#define PG8_STAGE(bufoff, gbase, voff) do { _Pragma("unroll") for (int _i = 0; _i < 2; ++_i) \
        __builtin_amdgcn_global_load_lds((const unsigned*)((const char*)(gbase) + (voff)[_i]), (LAS unsigned*)(lds + (bufoff) + ldsw + _i * 8192), 16, 0, 0); } while (0)
#define PG8_LDA(dst, b, h) do { _Pragma("unroll") for (int m = 0; m < 4; ++m) _Pragma("unroll") for (int k = 0; k < 2; ++k) dst[m][k] = *(const LAS bf16x8*)(lds + PG8_SA(b, h) + aoff + m * 2048 + k * 1024); } while (0)
#define PG8_LDB(dst, b, h) do { _Pragma("unroll") for (int n = 0; n < 2; ++n) _Pragma("unroll") for (int k = 0; k < 2; ++k) dst[n][k] = *(const LAS bf16x8*)(lds + PG8_SB(b, h) + boff + n * 2048 + k * 1024); } while (0)
#define PG8_MMA(ai, bj, At, Bt) do { __builtin_amdgcn_s_setprio(1); _Pragma("unroll") for (int m = 0; m < 4; ++m) _Pragma("unroll") for (int n = 0; n < 2; ++n) _Pragma("unroll") for (int k = 0; k < 2; ++k) \
        acc[ai][bj][m][n] = __builtin_amdgcn_mfma_f32_16x16x32_bf16(Bt[n][k], At[m][k], acc[ai][bj][m][n], 0, 0, 0); __builtin_amdgcn_s_setprio(0); } while (0)
#define PG8_WAIT_V(n) asm volatile("s_waitcnt vmcnt(" #n ")" ::: "memory")
#define PG8_WAIT_L(n) asm volatile("s_waitcnt lgkmcnt(" #n ")" ::: "memory")
#define PG8_BAR __builtin_amdgcn_s_barrier()
#define PG8_SCHED __builtin_amdgcn_sched_barrier(0)
    Unit cur, nxt; int ui = 0;
    if (!S.next(0, cur)) return;
    f32x4 acc[2][2][4][2];
#pragma unroll
    for (int a = 0; a < 2; ++a)
#pragma unroll
        for (int b = 0; b < 2; ++b)
#pragma unroll
            for (int m = 0; m < 4; ++m)
#pragma unroll
                for (int n = 0; n < 2; ++n) acc[a][b][m][n] = (f32x4){0.f, 0.f, 0.f, 0.f};
    bf16x8 At[4][2], B0[2][2], B1[2][2];
    const char* cA = (const char*)g.A + (size_t)cur.pm * tstep; const char* cB = (const char*)g.Bt + (size_t)cur.pn * tstep;
    if constexpr (SP2) {
        PG8_STAGE(PG8_SB(0, 0), cB, voffB); PG8_STAGE(PG8_SB(0, 1), cB + hstep, voffB); PG8_STAGE(PG8_SA(0, 0), cA, voffA); PG8_STAGE(PG8_SA(0, 1), cA + hstep, voffA);
        if (wr == 1) PG8_BAR;
        PG8_WAIT_V(2); PG8_BAR;
        PG8_STAGE(PG8_SB(1, 0), cB + kstep, voffB); PG8_STAGE(PG8_SA(1, 0), cA + kstep, voffA); PG8_STAGE(PG8_SB(1, 1), cB + hstep + kstep, voffB);
        PG8_WAIT_V(6); PG8_BAR;
    } else {
        PG8_STAGE(PG8_SB(0, 0), cB, voffB); PG8_STAGE(PG8_SA(0, 0), cA, voffA); PG8_STAGE(PG8_SB(0, 1), cB + hstep, voffB); PG8_STAGE(PG8_SA(0, 1), cA + hstep, voffA);
        if (wr == 1) PG8_BAR;
        PG8_WAIT_V(4); PG8_BAR;
        PG8_STAGE(PG8_SB(1, 0), cB + kstep, voffB); PG8_STAGE(PG8_SA(1, 0), cA + kstep, voffA); PG8_STAGE(PG8_SB(1, 1), cB + hstep + kstep, voffB);
        PG8_WAIT_V(6); PG8_BAR;
    }
    for (;;) {
        const bool has_next = S.next(ui + 1, nxt);
        const char* nA = has_next ? (const char*)g.A + (size_t)nxt.pm * tstep : cA; const char* nB = has_next ? (const char*)g.Bt + (size_t)nxt.pn * tstep : cB;
        for (int t = 0; t < nt; t += 2) {
            const bool last = (t == nt - 2);
            const char* a1 = cA + (size_t)(t + 1) * kstep;
            const char* a2 = last ? nA : cA + (size_t)(t + 2) * kstep; const char* b2 = last ? nB : cB + (size_t)(t + 2) * kstep;
            const char* a3 = a2 + kstep; const char* b3 = b2 + kstep;
            if constexpr (SP2) {
            PG8_LDB(B0, 0, 0); PG8_LDB(B1, 0, 1); PG8_SCHED; PG8_LDA(At, 0, 0); PG8_STAGE(PG8_SA(1, 1), a1 + hstep, voffA);
            PG8_WAIT_V(8); PG8_WAIT_L(0); PG8_BAR; PG8_MMA(0, 0, At, B0); PG8_MMA(0, 1, At, B1); PG8_BAR; PG8_SCHED;
            PG8_LDA(At, 0, 1); PG8_STAGE(PG8_SB(0, 0), b2, voffB); PG8_STAGE(PG8_SB(0, 1), b2 + hstep, voffB); PG8_STAGE(PG8_SA(0, 0), a2, voffA);
            PG8_WAIT_V(8); PG8_WAIT_L(0); PG8_BAR; PG8_MMA(1, 0, At, B0); PG8_MMA(1, 1, At, B1); PG8_BAR; PG8_SCHED;
            PG8_LDB(B0, 1, 0); PG8_LDB(B1, 1, 1); PG8_SCHED; PG8_LDA(At, 1, 0); PG8_STAGE(PG8_SA(0, 1), a2 + hstep, voffA);
            PG8_WAIT_V(8); PG8_WAIT_L(0); PG8_BAR; PG8_MMA(0, 0, At, B0); PG8_MMA(0, 1, At, B1); PG8_BAR; PG8_SCHED;
            PG8_LDA(At, 1, 1); PG8_STAGE(PG8_SB(1, 0), b3, voffB); PG8_STAGE(PG8_SB(1, 1), b3 + hstep, voffB); PG8_STAGE(PG8_SA(1, 0), a3, voffA);
            PG8_WAIT_V(8); PG8_WAIT_L(0); PG8_BAR; PG8_MMA(1, 0, At, B0); PG8_MMA(1, 1, At, B1); PG8_BAR; PG8_SCHED;
            } else {
            PG8_LDB(B0, 0, 0); PG8_SCHED; PG8_LDA(At, 0, 0); PG8_STAGE(PG8_SA(1, 1), a1 + hstep, voffA);
            PG8_WAIT_L(8); PG8_BAR; PG8_WAIT_L(0); PG8_MMA(0, 0, At, B0); PG8_BAR; PG8_SCHED;
            PG8_LDB(B1, 0, 1); PG8_STAGE(PG8_SB(0, 0), b2, voffB);
            PG8_BAR; PG8_WAIT_L(0); PG8_MMA(0, 1, At, B1); PG8_BAR;
            PG8_LDA(At, 0, 1); PG8_STAGE(PG8_SA(0, 0), a2, voffA);
            PG8_BAR; PG8_WAIT_L(0); PG8_MMA(1, 0, At, B0); PG8_BAR; PG8_SCHED;
            PG8_STAGE(PG8_SB(0, 1), b2 + hstep, voffB);
            PG8_WAIT_V(6); PG8_BAR; PG8_MMA(1, 1, At, B1); PG8_BAR;
            PG8_LDB(B0, 1, 0); PG8_SCHED; PG8_LDA(At, 1, 0); PG8_STAGE(PG8_SA(0, 1), a2 + hstep, voffA);
            PG8_WAIT_L(8); PG8_BAR; PG8_WAIT_L(0); PG8_MMA(0, 0, At, B0); PG8_BAR; PG8_SCHED;
            PG8_LDB(B1, 1, 1); PG8_STAGE(PG8_SB(1, 0), b3, voffB);
            PG8_BAR; PG8_WAIT_L(0); PG8_MMA(0, 1, At, B1); PG8_BAR;
            PG8_LDA(At, 1, 1); PG8_STAGE(PG8_SA(1, 0), a3, voffA);
            PG8_BAR; PG8_WAIT_L(0); PG8_MMA(1, 0, At, B0); PG8_BAR; PG8_SCHED;
            PG8_STAGE(PG8_SB(1, 1), b3 + hstep, voffB);
            PG8_WAIT_V(6); PG8_BAR; PG8_MMA(1, 1, At, B1); PG8_BAR;
            }
        }
        if constexpr (ALIGN_EPI) { if (wr == 0) PG8_BAR; }
        E(acc, cur, wr, wc, fr, fq);
        if (!has_next) break;
#pragma unroll
        for (int a = 0; a < 2; ++a)
#pragma unroll
            for (int b = 0; b < 2; ++b)
#pragma unroll
                for (int m = 0; m < 4; ++m)
#pragma unroll
                    for (int n = 0; n < 2; ++n) acc[a][b][m][n] = (f32x4){0.f, 0.f, 0.f, 0.f};
        cur = nxt; cA = nA; cB = nB; ++ui;
        if constexpr (ALIGN_EPI) { if (wr == 1) PG8_BAR; }
    }
    PG8_WAIT_V(0);
    if constexpr (!ALIGN_EPI) { if (wr == 0) PG8_BAR; }
    PG8_BAR;
#undef PG8_SA
#undef PG8_SB
#undef PG8_STAGE
#undef PG8_LDA
#undef PG8_LDB
#undef PG8_MMA
#undef PG8_WAIT_V
#undef PG8_WAIT_L
#undef PG8_BAR
#undef PG8_SCHED
}
}

struct Args { const void* in[24]; float* out; unsigned char* ws; };
enum { I_X = 0, I_C, I_POS, I_ADAW, I_ADAB, I_N1G, I_N2G, I_ABWIN, I_QNG, I_KNG, I_SINKS, I_VNG, I_GMWS, I_GMB, I_ABWOUT, I_CWIN, I_CLB, I_CONG, I_CWOUT, I_RW, I_RB, I_WG, I_WU, I_WD };

struct Ctx { int tid, lane, wave, G, bid; LAS unsigned char* lds; unsigned char* ws; };
constexpr int INP_OFF = MISC_OFF + 512;
__device__ __forceinline__ const void* in_ptr(const Ctx& c, int i) {
    const unsigned long long v = ((const LAS unsigned long long*)(c.lds + INP_OFF))[i];
    return (const void*)(((unsigned long long)(unsigned)__builtin_amdgcn_readfirstlane((int)(unsigned)(v >> 32)) << 32) | (unsigned long long)(unsigned)__builtin_amdgcn_readfirstlane((int)(unsigned)v));
}

__device__ __forceinline__ void p0_ada(const Ctx& c) {
    LAS float* cond = (LAS float*)c.lds;
    LAS float* red = (LAS float*)(c.lds + 32768);
    const float* cin = (const float*)in_ptr(c, I_C); const float* adaw = (const float*)in_ptr(c, I_ADAW); const float* adab = (const float*)in_ptr(c, I_ADAB);
    float* MOD = (float*)(c.ws + WS_MOD);
    for (int i = c.tid; i < NBATCH * D; i += 512) { const float v = cin[i]; cond[i] = v * sigmoidf_(v); }
    __syncthreads();
    for (int u = c.bid; u < 256; u += c.G) {
        const int col0 = u * 192, l = col0 / 12288, j0 = col0 % 12288;
        const float* W = adaw + (size_t)l * D * 12288 + j0;
        f32x4 acc[4];
#pragma unroll
        for (int b = 0; b < 4; ++b) acc[b] = (f32x4){0.f, 0.f, 0.f, 0.f};
        if (c.lane < 48) {
            for (int k = c.wave; k < D; k += 128) {
                f32x4 w[16];
#pragma unroll
                for (int r = 0; r < 16; ++r) w[r] = __builtin_nontemporal_load((const f32x4*)(W + (size_t)(k + 8 * r) * 12288 + 4 * c.lane));
#pragma unroll
                for (int r = 0; r < 16; ++r)
#pragma unroll
                    for (int b = 0; b < 4; ++b) acc[b] += w[r] * cond[b * D + k + 8 * r];
            }
#pragma unroll
            for (int b = 0; b < 4; ++b) *(LAS f32x4*)(red + ((c.wave * 4 + b) * 192 + 4 * c.lane)) = acc[b];
        }
        __syncthreads();
        for (int o = c.tid; o < 768; o += 512) { const int b = o / 192, jj = o % 192; float s = 0.f;
#pragma unroll
            for (int w = 0; w < 8; ++w) s += red[(w * 4 + b) * 192 + jj];
            MOD[(size_t)(l * 4 + b) * 12288 + j0 + jj] = s + adab[l * 12288 + j0 + jj]; }
        __syncthreads();
    }
}
__device__ __forceinline__ void p0_tr_item(const float* W, int K, int N, bf16_t* WT, int item, int kind, LAS float* scr, int lane) {
    const int nblk = N >> 6, kb = item / nblk, nb = item - kb * nblk, k0 = 64 * kb, n0 = 64 * nb;
    f32x4 v[16];
#pragma unroll
    for (int i = 0; i < 16; ++i) { const int kk = 4 * i + (lane >> 4); v[i] = __builtin_nontemporal_load((const f32x4*)(W + (size_t)(k0 + kk) * N + n0 + 4 * (lane & 15))); }
#pragma unroll
    for (int i = 0; i < 16; ++i) { const int kk = 4 * i + (lane >> 4); LAS float* p = scr + kk * 65 + 4 * (lane & 15); p[0] = v[i][0]; p[1] = v[i][1]; p[2] = v[i][2]; p[3] = v[i][3]; }
    asm volatile("s_waitcnt lgkmcnt(0)" ::: "memory");
    int drow0 = n0;
    if (kind == 1) drow0 = 256 * (n0 >> 7) + (n0 & 127);
    if (kind == 2) drow0 = 256 * (n0 >> 7) + 128 + (n0 & 127);
    const int cc = lane & 7;
#pragma unroll
    for (int jj = 0; jj < 8; ++jj) { const int n = (lane >> 3) + 8 * jj; const LAS float* s = scr + (8 * cc) * 65 + n;
        u32x4 o; o.x = cvt_pk_bf16(s[0 * 65], s[1 * 65]); o.y = cvt_pk_bf16(s[2 * 65], s[3 * 65]); o.z = cvt_pk_bf16(s[4 * 65], s[5 * 65]); o.w = cvt_pk_bf16(s[6 * 65], s[7 * 65]);
        __builtin_nontemporal_store(o, (u32x4*)(WT + (size_t)(drow0 + n) * K + k0 + 8 * cc)); }
    asm volatile("s_waitcnt lgkmcnt(0)" ::: "memory");
}
__device__ __forceinline__ void p0_convert(const Ctx& c) {
    LAS float* scr = (LAS float*)(c.lds + c.wave * 16640);
    const int gw = c.bid * 8 + c.wave, NGW = c.G * 8;
    constexpr int I_ABI = 32 * 56, I_SQ = 32 * 32, I_CI = 32 * 128, I_DENSE = 2 * (I_ABI + I_SQ + I_CI + I_SQ), I_MOE = 16 * 768;
    for (int it = gw; it < I_DENSE + I_MOE; it += NGW) {
        int r = it;
        if (r < I_DENSE) {
            const int i = r / (I_ABI + I_SQ + I_CI + I_SQ); r -= i * (I_ABI + I_SQ + I_CI + I_SQ);
            if (r < I_ABI) { p0_tr_item((const float*)in_ptr(c, I_ABWIN) + (size_t)i * D * ABIN, D, ABIN, (bf16_t*)(c.ws + WS_WABIN) + (size_t)i * ABIN * D, r, 0, scr, c.lane); continue; } r -= I_ABI;
            if (r < I_SQ) { p0_tr_item((const float*)in_ptr(c, I_ABWOUT) + (size_t)i * D * D, D, D, (bf16_t*)(c.ws + WS_WABOUT) + (size_t)i * D * D, r, 0, scr, c.lane); continue; } r -= I_SQ;
            if (r < I_CI) { p0_tr_item((const float*)in_ptr(c, I_CWIN) + (size_t)i * D * CIN, D, CIN, (bf16_t*)(c.ws + WS_WCIN) + (size_t)i * CIN * D, r, 0, scr, c.lane); continue; } r -= I_CI;
            p0_tr_item((const float*)in_ptr(c, I_CWOUT) + (size_t)i * D * D, D, D, (bf16_t*)(c.ws + WS_WCOUT) + (size_t)i * D * D, r, 0, scr, c.lane);
        } else {
            r -= I_DENSE; const int le = r / 768, q = r - le * 768, which = q >> 8, item = q & 255;
            if (which == 0) p0_tr_item((const float*)in_ptr(c, I_WG) + (size_t)le * D * DE, D, DE, (bf16_t*)(c.ws + WS_WGU) + (size_t)le * 1024 * D, item, 1, scr, c.lane);
            else if (which == 1) p0_tr_item((const float*)in_ptr(c, I_WU) + (size_t)le * D * DE, D, DE, (bf16_t*)(c.ws + WS_WGU) + (size_t)le * 1024 * D, item, 2, scr, c.lane);
            else p0_tr_item((const float*)in_ptr(c, I_WD) + (size_t)le * DE * D, DE, D, (bf16_t*)(c.ws + WS_WDN) + (size_t)le * D * DE, item, 0, scr, c.lane);
        }
    }
}
__device__ __forceinline__ void moe_conv_tail(const Ctx& c, int L, int which, int rank, int nidle) {
    if (rank < 0) return;
    LAS float* scr = (LAS float*)(c.lds + c.wave * 16640);
    const int n = which == 0 ? 8192 : 4096;
    for (int it = rank * 8 + c.wave; it < n; it += nidle * 8) {
        if (which == 0) { const int le = L * 16 + (it >> 9), q = it & 511;
            if (q < 256) p0_tr_item((const float*)in_ptr(c, I_WG) + (size_t)le * D * DE, D, DE, (bf16_t*)(c.ws + WS_WGU) + (size_t)le * 1024 * D, q, 1, scr, c.lane);
            else p0_tr_item((const float*)in_ptr(c, I_WU) + (size_t)le * D * DE, D, DE, (bf16_t*)(c.ws + WS_WGU) + (size_t)le * 1024 * D, q - 256, 2, scr, c.lane); }
        else { const int le = L * 16 + (it >> 8);
            p0_tr_item((const float*)in_ptr(c, I_WD) + (size_t)le * DE * D, DE, D, (bf16_t*)(c.ws + WS_WDN) + (size_t)le * D * DE, it & 255, 0, scr, c.lane); }
    }
}
__device__ __forceinline__ void p0_lb(const Ctx& c) {
    if (c.bid != 0) return;
    const float* clb = (const float*)in_ptr(c, I_CLB); float* LB = (float*)(c.ws + WS_LB);
    for (int k = c.tid; k < D; k += 512) {
        const float v0 = clb[k], v1 = clb[D + k], v2 = clb[2 * D + k], v3 = clb[3 * D + k];
        const float m = fmaxf(fmaxf(v0, v1), fmaxf(v2, v3));
        const float e0 = __expf(v0 - m), e1 = __expf(v1 - m), e2 = __expf(v2 - m), e3 = __expf(v3 - m); const float inv = 1.0f / (e0 + e1 + e2 + e3);
        LB[k] = 0.f; LB[D + k] = e1 * inv; LB[2 * D + k] = (e1 + e2) * inv; LB[3 * D + k] = (e1 + e2 + e3) * inv;
    }
}

__device__ __forceinline__ void moe_tables(const Ctx& c, int l, LAS int* pb) {
    __syncthreads();
    if (c.tid == 0) { const unsigned* cnt = (const unsigned*)(c.ws + WS_CTL) + CW_CNT + l * 16 * 64; int acc = 0;
        for (int e = 0; e < NE; ++e) { const int n = (int)cnt[e * 64]; pb[e] = acc; pb[17 + e] = n; acc += (n + 255) >> 8; }
        pb[16] = acc; }
    __syncthreads();
}

__device__ __forceinline__ float treduce32(const float (&p)[32], int lane) {
    float a16[16], a8[8], a4[4], a2[2], a1;
    { const bool up = (lane & 32) != 0;
#pragma unroll
      for (int j = 0; j < 16; ++j) { const float send = up ? p[j] : p[j + 16]; a16[j] = (up ? p[j + 16] : p[j]) + get_x32(send, up); } }
    { const bool up = (lane & 16) != 0;
#pragma unroll
      for (int j = 0; j < 8; ++j) { const float send = up ? a16[j] : a16[j + 8]; a8[j] = (up ? a16[j + 8] : a16[j]) + sx<16>(send); } }
    { const bool up = (lane & 8) != 0;
#pragma unroll
      for (int j = 0; j < 4; ++j) { const float send = up ? a8[j] : a8[j + 4]; a4[j] = (up ? a8[j + 4] : a8[j]) + sx<8>(send); } }
    { const bool up = (lane & 4) != 0;
#pragma unroll
      for (int j = 0; j < 2; ++j) { const float send = up ? a4[j] : a4[j + 2]; a2[j] = (up ? a4[j + 2] : a4[j]) + sx<4>(send); } }
    { const bool up = (lane & 2) != 0; const float send = up ? a2[0] : a2[1]; a1 = (up ? a2[1] : a2[0]) + sx<2>(send); }
    return a1 + sx<1>(a1);
}
__device__ __forceinline__ float treduce16(const float (&p)[16], int lane) {
    float r8[8], r4[4], r2[2], r1;
    { const bool up = (lane & 32) != 0;
#pragma unroll
      for (int j = 0; j < 8; ++j) { const float send = up ? p[j] : p[j + 8]; r8[j] = (up ? p[j + 8] : p[j]) + get_x32(send, up); } }
    { const bool up = (lane & 16) != 0;
#pragma unroll
      for (int j = 0; j < 4; ++j) { const float send = up ? r8[j] : r8[j + 4]; r4[j] = (up ? r8[j + 4] : r8[j]) + sx<16>(send); } }
    { const bool up = (lane & 8) != 0;
#pragma unroll
      for (int j = 0; j < 2; ++j) { const float send = up ? r4[j] : r4[j + 2]; r2[j] = (up ? r4[j + 2] : r4[j]) + sx<8>(send); } }
    { const bool up = (lane & 4) != 0; const float send = up ? r2[0] : r2[1]; r1 = (up ? r2[1] : r2[0]) + sx<4>(send); }
    r1 += sx<2>(r1); r1 += sx<1>(r1);
    return r1;
}
namespace ns { constexpr int PARTS = 0, RSTD = 1024, RA = 1280, RB = 1408, RPART = 2048, LOGIT = 18432, SEL = 20480; }
template <int MODE, bool DRY = false>
__device__ __forceinline__ void norm_phase(const Ctx& c, int l) {
    using namespace ns;
    constexpr int R = 32;
    float* X = (float*)in_ptr(c, 24); const float* xin = (const float*)in_ptr(c, I_X);
    float* Xw = DRY ? (float*)(c.ws + WS_PROJ) : X;
    bf16_t* H = (bf16_t*)(c.ws + (DRY ? WS_LOGF : WS_H)); const bf16_t* Y = (const bf16_t*)(c.ws + WS_Y);
    const float* MOD = (const float*)(c.ws + WS_MOD);
    LAS unsigned char* L = c.lds;
    LAS int* pb = (LAS int*)(c.lds + MISC_OFF) + 16;
    const bool combine = (MODE == 2) || (MODE == 0 && l > 0);
    const int lp = (MODE == 2) ? DEPTH - 1 : l - 1;
    if (combine) moe_tables(c, lp, pb);
    const int col = 256 * c.wave + 4 * c.lane;
    const int* tokinfo = (const int*)(c.ws + WS_TOKINFO);
    f32x4 rwv[4][4];
    if (MODE == 1) { const float* rwg = (const float*)in_ptr(c, I_RW);
#pragma unroll
        for (int q = 0; q < 4; ++q)
#pragma unroll
            for (int e4 = 0; e4 < 4; ++e4) rwv[q][e4] = *(const f32x4*)(rwg + (size_t)(col + q) * 16 + 4 * e4); }
    const int vcu = (c.G % 8 == 0) ? (c.bid % 8) * (c.G / 8) + c.bid / 8 : c.bid;
    for (int grp = vcu; grp < T / R; grp += c.G) {
        const int row0 = grp * R, b = row0 >> 11;
        __syncthreads();
        if (combine && c.tid < R) { const int ia = tokinfo[(row0 + c.tid) * 2], ib = tokinfo[(row0 + c.tid) * 2 + 1];
            ((LAS int*)(L + RA))[c.tid] = pb[ia >> 16] * 256 + (ia & 0xffff); ((LAS int*)(L + RB))[c.tid] = pb[ib >> 16] * 256 + (ib & 0xffff); }
        f32x4 xv[R];
        { const float* xs = ((MODE == 0 && l == 0) ? xin : X) + (size_t)row0 * D + col;
#pragma unroll
          for (int r = 0; r < R; ++r) xv[r] = *(const f32x4*)(xs + (size_t)r * D); }
        if (combine) {
            __syncthreads();
            const f32x4 g2 = *(const f32x4*)(MOD + (size_t)(lp * 4 + b) * 12288 + 5 * D + col);
#pragma unroll
            for (int r = 0; r < R; ++r) { const int ra = ((const LAS int*)(L + RA))[r], rb = ((const LAS int*)(L + RB))[r];
                const u32x2 wa = *(const u32x2*)(Y + (size_t)ra * D + col), wb = *(const u32x2*)(Y + (size_t)rb * D + col);
                xv[r][0] += g2[0] * (bf_lo(wa.x) + bf_lo(wb.x)); xv[r][1] += g2[1] * (bf_hi(wa.x) + bf_hi(wb.x)); xv[r][2] += g2[2] * (bf_lo(wa.y) + bf_lo(wb.y)); xv[r][3] += g2[3] * (bf_hi(wa.y) + bf_hi(wb.y)); }
        }
        if (MODE == 2 || (MODE == 0 && l > 0)) {
#pragma unroll
            for (int r = 0; r < R; ++r) *(f32x4*)(Xw + (size_t)(row0 + r) * D + col) = xv[r];
        }
        if (MODE == 2) continue;
        { float ps[R];
#pragma unroll
          for (int r = 0; r < R; ++r) ps[r] = (xv[r][0] * xv[r][0] + xv[r][1] * xv[r][1]) + (xv[r][2] * xv[r][2] + xv[r][3] * xv[r][3]);
          const float tot = treduce32(ps, c.lane); if ((c.lane & 1) == 0) ((LAS float*)(L + PARTS))[c.wave * 32 + (c.lane >> 1)] = tot; }
        __syncthreads();
        if (c.tid < R) { float s = 0.f;
#pragma unroll
            for (int w = 0; w < 8; ++w) s += ((const LAS float*)(L + PARTS))[w * 32 + c.tid];
            ((LAS float*)(L + RSTD))[c.tid] = rsqrtf(s * (1.0f / D) + EPS); }
        __syncthreads();
        const float* ng = (const float*)in_ptr(c, MODE == 0 ? I_N1G : I_N2G) + l * D; const float* sh = MOD + (size_t)(l * 4 + b) * 12288 + (MODE == 0 ? 0 : 3 * D);
        const f32x4 A = *(const f32x4*)(ng + col) * (*(const f32x4*)(sh + D + col) + 1.0f), B = *(const f32x4*)(sh + col);
        if (MODE == 0) {
#pragma unroll
            for (int r = 0; r < R; ++r) xv[r] = xv[r] * (A * ((const LAS float*)(L + RSTD))[r]) + B; }
        if (MODE == 0) {
#pragma unroll
            for (int r = 0; r < R; ++r) { u32x2 w; w.x = cvt_pk_bf16(xv[r][0], xv[r][1]); w.y = cvt_pk_bf16(xv[r][2], xv[r][3]); *(u32x2*)(H + (size_t)(row0 + r) * D + col) = w; }
            continue;
        }
        u32x2 hpk[R];
#pragma unroll
        for (int r = 0; r < R; ++r) { const f32x4 hv = xv[r] * (A * ((const LAS float*)(L + RSTD))[r]) + B; float p[16];
#pragma unroll
            for (int e4 = 0; e4 < 4; ++e4) { const f32x4 a = rwv[0][e4] * hv[0] + rwv[1][e4] * hv[1] + rwv[2][e4] * hv[2] + rwv[3][e4] * hv[3]; p[4 * e4] = a[0]; p[4 * e4 + 1] = a[1]; p[4 * e4 + 2] = a[2]; p[4 * e4 + 3] = a[3]; }
            const float tot = treduce16(p, c.lane);
            if ((c.lane & 3) == 0) ((LAS float*)(L + RPART))[(c.wave * R + r) * 16 + (c.lane >> 2)] = tot;
            hpk[r].x = cvt_pk_bf16(hv[0], hv[1]); hpk[r].y = cvt_pk_bf16(hv[2], hv[3]); }
        __syncthreads();
        if (c.tid < R * 16) { float lg = 0.f;
#pragma unroll
          for (int w = 0; w < 8; ++w) lg += ((const LAS float*)(L + RPART))[w * (R * 16) + c.tid];
          ((LAS float*)(L + LOGIT))[c.tid] = lg; }
        __syncthreads();
        if (c.tid < R) {
            const float* rb = (const float*)in_ptr(c, I_RB); const int row = row0 + c.tid;
            float sc16[16], sel[16];
#pragma unroll
            for (int e4 = 0; e4 < 4; ++e4) { const f32x4 lg = *(const LAS f32x4*)(L + LOGIT + (c.tid * 16 + 4 * e4) * 4);
#pragma unroll
                for (int q = 0; q < 4; ++q) { sc16[4 * e4 + q] = 1.0f / (1.0f + __expf(-lg[q])); sel[4 * e4 + q] = sc16[4 * e4 + q] + rb[4 * e4 + q]; } }
            float bestg = -1e30f; int be1 = 0, be2 = 0; float bs1 = 0.f, bs2 = 0.f;
#pragma unroll
            for (int g = 0; g < 4; ++g) {
                int e1 = 4 * g; float s1 = sel[4 * g], w1 = sc16[4 * g];
#pragma unroll
                for (int k = 1; k < 4; ++k) if (sel[4 * g + k] > s1) { s1 = sel[4 * g + k]; w1 = sc16[4 * g + k]; e1 = 4 * g + k; }
                int e2 = -1; float s2 = -1e30f, w2 = 0.f;
#pragma unroll
                for (int k = 0; k < 4; ++k) if ((4 * g + k) != e1 && sel[4 * g + k] > s2) { s2 = sel[4 * g + k]; w2 = sc16[4 * g + k]; e2 = 4 * g + k; }
                const float gs = s1 + s2;
                if (gs > bestg) { bestg = gs; be1 = e1; be2 = e2; bs1 = w1; bs2 = w2; }
            }
            unsigned* cnt = (unsigned*)(c.ws + WS_CTL) + CW_CNT + (DRY ? 4 + l : l) * 16 * 64;
            const unsigned sa = __hip_atomic_fetch_add(cnt + be1 * 64, 1u, __ATOMIC_RELAXED, __HIP_MEMORY_SCOPE_AGENT) + (DRY ? 4096u : 0u);
            const unsigned sb = __hip_atomic_fetch_add(cnt + be2 * 64, 1u, __ATOMIC_RELAXED, __HIP_MEMORY_SCOPE_AGENT) + (DRY ? 4096u : 0u);
            const float inv = 1.0f / (bs1 + bs2);
            float* gwp = (float*)(c.ws + WS_GW); int* ti = (int*)(c.ws + (DRY ? WS_LIST : WS_TOKINFO));
            gwp[be1 * 8192 + sa] = bs1 * inv; gwp[be2 * 8192 + sb] = bs2 * inv;
            ti[row * 2] = (be1 << 16) | (int)sa; ti[row * 2 + 1] = (be2 << 16) | (int)sb;
            *(LAS u32x2*)(L + SEL + c.tid * 8) = (u32x2){(unsigned)(be1 * 8192) + sa, (unsigned)(be2 * 8192) + sb};
        }
        __syncthreads();
        { bf16_t* AS = (bf16_t*)(c.ws + WS_ASORT);
#pragma unroll
          for (int r = 0; r < R; ++r) { const u32x2 d = *(const LAS u32x2*)(L + SEL + r * 8); *(u32x2*)(AS + (size_t)d.x * D + col) = hpk[r]; *(u32x2*)(AS + (size_t)d.y * D + col) = hpk[r]; } }
    }
}
__device__ __forceinline__ bf16x8 pack8(f32x4 a, f32x4 b) { u32x4 w; w.x = cvt_pk_bf16(a[0], a[1]); w.y = cvt_pk_bf16(a[2], a[3]); w.z = cvt_pk_bf16(b[0], b[1]); w.w = cvt_pk_bf16(b[2], b[3]); return __builtin_bit_cast(bf16x8, w); }
__device__ __forceinline__ float max_x32(float v) { const unsigned x = (unsigned)__float_as_int(v); const auto r = __builtin_amdgcn_permlane32_swap(x, x, false, false); return fmaxf(__int_as_float((int)r[0]), __int_as_float((int)r[1])); }
__device__ __forceinline__ void attn_mfma(const Ctx& c, int li) {
    const bf16_t* P = (const bf16_t*)(c.ws + WS_PROJ); bf16_t* MIX = (bf16_t*)(c.ws + WS_MIX);
    const float* sinks = (const float*)in_ptr(c, I_SINKS) + li * 16;
    const int* pos = (const int*)in_ptr(c, I_POS); const float* qg = (const float*)in_ptr(c, I_QNG) + li * 64; const float* kg = (const float*)in_ptr(c, I_KNG) + li * 64;
    LAS unsigned char* Ks = c.lds;
    LAS unsigned char* Vt = c.lds + 39168;
    const int fr = c.lane & 15, fq = c.lane >> 4;
    for (int unit = c.bid; unit < 256; unit += c.G) {
        const int g = unit & 3, nb = (unit >> 2) & 15, b = unit >> 6, tok0 = b * SEQ + nb * 128;
        __syncthreads();
        { const int j8 = c.tid & 7;
          float invf[8], kgv[8];
#pragma unroll
          for (int q = 0; q < 8; ++q) { invf[q] = __builtin_amdgcn_exp2f(-(float)(8 * (j8 & 3) + q) * (13.287712379549449f / 32.0f)) * 0.15915494309189535f; kgv[q] = kg[8 * j8 + q]; }
#pragma unroll
          for (int pass = 0; pass < 4; ++pass) { const int kr = pass * 64 + (c.tid >> 3); const bool valid = (nb > 0) || (kr >= 128);
              u32x4 kw = (u32x4){0u, 0u, 0u, 0u}; float posf = 0.f;
              if (valid) { const bf16_t* src = P + (size_t)(tok0 - 128 + kr) * ABIN + 1024 + g * 64 + 8 * j8; kw = *(const u32x4*)src; posf = (float)pos[tok0 - 128 + kr]; }
              float x[8] = {bf_lo(kw.x), bf_hi(kw.x), bf_lo(kw.y), bf_hi(kw.y), bf_lo(kw.z), bf_hi(kw.z), bf_lo(kw.w), bf_hi(kw.w)};
              float ss = 0.f;
#pragma unroll
              for (int q = 0; q < 8; ++q) ss += x[q] * x[q];
              ss += sx<1>(ss); ss += sx<2>(ss); ss += sx<4>(ss);
              const float rstd = rsqrtf(ss * (1.0f / 64.0f) + EPS);
              float y[8];
#pragma unroll
              for (int q = 0; q < 8; ++q) x[q] = x[q] * rstd * kgv[q];
#pragma unroll
              for (int q = 0; q < 8; ++q) { const float other = sx<4>(x[q]); float rev = posf * invf[q]; rev = rev - floorf(rev);
                  const float sn = __builtin_amdgcn_sinf(rev), cs = __builtin_amdgcn_cosf(rev); y[q] = (j8 < 4) ? (x[q] * cs - other * sn) : (x[q] * cs + other * sn); }
              kw.x = cvt_pk_bf16(y[0], y[1]); kw.y = cvt_pk_bf16(y[2], y[3]); kw.z = cvt_pk_bf16(y[4], y[5]); kw.w = cvt_pk_bf16(y[6], y[7]);
              *(LAS u32x4*)(Ks + kr * 144 + 16 * j8) = kw; }
#pragma unroll
          for (int pass = 0; pass < 4; ++pass) { const int e = pass * 512 + c.tid, kr = e & 255, dg = e >> 8; const bool valid = (nb > 0) || (kr >= 128);
              u32x4 vw = (u32x4){0u, 0u, 0u, 0u};
              if (valid) vw = *(const u32x4*)(P + (size_t)(tok0 - 128 + kr) * ABIN + 1280 + g * 64 + 8 * dg);
              LAS bf16_t* vt = (LAS bf16_t*)Vt + (8 * dg) * 280 + kr;
              vt[0 * 280] = (bf16_t)(vw.x & 0xffffu); vt[1 * 280] = (bf16_t)(vw.x >> 16); vt[2 * 280] = (bf16_t)(vw.y & 0xffffu); vt[3 * 280] = (bf16_t)(vw.y >> 16);
              vt[4 * 280] = (bf16_t)(vw.z & 0xffffu); vt[5 * 280] = (bf16_t)(vw.z >> 16); vt[6 * 280] = (bf16_t)(vw.w & 0xffffu); vt[7 * 280] = (bf16_t)(vw.w >> 16); }
          if (c.tid < 144) *(LAS u32x4*)(Ks + 256 * 144 + 16 * c.tid) = (u32x4){0u, 0u, 0u, 0u};
          if (c.tid < 128) *(LAS u32x4*)(Vt + (c.tid >> 1) * 560 + 512 + 16 * (c.tid & 1)) = (u32x4){0u, 0u, 0u, 0u}; }
        const int r = c.wave >> 1, half = c.wave & 1, head = g * 4 + r;
        bf16x8 qf[4][2];
        { float invq[8], qg0[8], qg1[8];
#pragma unroll
          for (int q = 0; q < 8; ++q) { invq[q] = __builtin_amdgcn_exp2f(-(float)(8 * fq + q) * (13.287712379549449f / 32.0f)) * 0.15915494309189535f; qg0[q] = qg[8 * fq + q]; qg1[q] = qg[32 + 8 * fq + q]; }
#pragma unroll
          for (int i = 0; i < 4; ++i) { const int tokq = tok0 + 64 * half + 16 * i + fr; const bf16_t* qp = P + (size_t)tokq * ABIN + head * 64 + 8 * fq;
              const u32x4 w0 = *(const u32x4*)qp, w1 = *(const u32x4*)(qp + 32); const float posf = (float)pos[tokq];
              float x1[8] = {bf_lo(w0.x), bf_hi(w0.x), bf_lo(w0.y), bf_hi(w0.y), bf_lo(w0.z), bf_hi(w0.z), bf_lo(w0.w), bf_hi(w0.w)};
              float x2[8] = {bf_lo(w1.x), bf_hi(w1.x), bf_lo(w1.y), bf_hi(w1.y), bf_lo(w1.z), bf_hi(w1.z), bf_lo(w1.w), bf_hi(w1.w)};
              float ss = 0.f;
#pragma unroll
              for (int q = 0; q < 8; ++q) ss += x1[q] * x1[q] + x2[q] * x2[q];
              ss += sx<16>(ss); ss = sum_x32(ss);
              const float rstd = rsqrtf(ss * (1.0f / 64.0f) + EPS) * 0.125f;
              float y1[8], y2[8];
#pragma unroll
              for (int q = 0; q < 8; ++q) { const float a1 = x1[q] * rstd * qg0[q], a2 = x2[q] * rstd * qg1[q]; float rev = posf * invq[q]; rev = rev - floorf(rev);
                  const float sn = __builtin_amdgcn_sinf(rev), cs = __builtin_amdgcn_cosf(rev); y1[q] = a1 * cs - a2 * sn; y2[q] = a2 * cs + a1 * sn; }
              u32x4 o0, o1; o0.x = cvt_pk_bf16(y1[0], y1[1]); o0.y = cvt_pk_bf16(y1[2], y1[3]); o0.z = cvt_pk_bf16(y1[4], y1[5]); o0.w = cvt_pk_bf16(y1[6], y1[7]);
              o1.x = cvt_pk_bf16(y2[0], y2[1]); o1.y = cvt_pk_bf16(y2[2], y2[3]); o1.z = cvt_pk_bf16(y2[4], y2[5]); o1.w = cvt_pk_bf16(y2[6], y2[7]);
              qf[i][0] = __builtin_bit_cast(bf16x8, o0); qf[i][1] = __builtin_bit_cast(bf16x8, o1); } }
        const float sink = sinks[head];
        __syncthreads();
#pragma unroll
        for (int i = 0; i < 4; ++i) {
            const int qt = 4 * half + i, iq = 16 * qt + fr;
            f32x4 sacc[10];
#pragma unroll
            for (int t = 0; t < 10; ++t) { sacc[t] = (f32x4){0.f, 0.f, 0.f, 0.f};
#pragma unroll
                for (int s2 = 0; s2 < 2; ++s2) { const bf16x8 kf = *(const LAS bf16x8*)(Ks + (16 * (qt + t) + fr) * 144 + 64 * s2 + 16 * fq); sacc[t] = __builtin_amdgcn_mfma_f32_16x16x32_bf16(kf, qf[i][s2], sacc[t], 0, 0, 0); } }
            float m = sink;
#pragma unroll
            for (int t = 0; t < 10; ++t)
#pragma unroll
                for (int q = 0; q < 4; ++q) { const int kj = 16 * (qt + t) + 4 * fq + q; const bool vis = (kj > iq) && (kj <= iq + 128) && (nb > 0 || kj >= 128);
                    const float sv = vis ? sacc[t][q] : -1e30f; sacc[t][q] = sv; m = fmaxf(m, sv); }
            m = fmaxf(m, sx<16>(m)); m = max_x32(m);
            float lsum = 0.f;
#pragma unroll
            for (int t = 0; t < 10; ++t)
#pragma unroll
                for (int q = 0; q < 4; ++q) { const float pv = __expf(sacc[t][q] - m); sacc[t][q] = pv; lsum += pv; }
            lsum += sx<16>(lsum); lsum = sum_x32(lsum);
            const float inv = 1.0f / (lsum + __expf(sink - m));
            f32x4 oacc[4];
#pragma unroll
            for (int dt = 0; dt < 4; ++dt) oacc[dt] = (f32x4){0.f, 0.f, 0.f, 0.f};
#pragma unroll
            for (int u = 0; u < 5; ++u) { const bf16x8 pf = pack8(sacc[2 * u] * inv, sacc[2 * u + 1] * inv);
#pragma unroll
                for (int dt = 0; dt < 4; ++dt) { const LAS unsigned char* vp = Vt + (16 * dt + fr) * 560 + (16 * (qt + 2 * u) + 4 * fq) * 2;
                    const u32x2 v0 = *(const LAS u32x2*)vp, v1 = *(const LAS u32x2*)(vp + 32); const u32x4 vv = (u32x4){v0.x, v0.y, v1.x, v1.y};
                    oacc[dt] = __builtin_amdgcn_mfma_f32_16x16x32_bf16(__builtin_bit_cast(bf16x8, vv), pf, oacc[dt], 0, 0, 0); } }
#pragma unroll
            for (int dt = 0; dt < 4; ++dt) { u32x2 w; w.x = cvt_pk_bf16(oacc[dt][0], oacc[dt][1]); w.y = cvt_pk_bf16(oacc[dt][2], oacc[dt][3]); *(u32x2*)(MIX + (size_t)(tok0 + 16 * qt + fr) * D + head * 64 + 16 * dt + 4 * fq) = w; }
        }
    }
}
__device__ __forceinline__ void gating_mfma(const Ctx& c, int li) {
    const bf16_t* P = (const bf16_t*)(c.ws + WS_PROJ); bf16_t* MIX = (bf16_t*)(c.ws + WS_MIX);
    const float* wsp = (const float*)in_ptr(c, I_GMWS) + (size_t)li * 8 * 128 * 128; const float* bsp = (const float*)in_ptr(c, I_GMB) + li * 8 * 128;
    LAS unsigned char* Wl = c.lds;
    LAS unsigned char* Vn = c.lds + 34816;
    LAS unsigned char* MR = c.lds + 69632;
    const float* STATS = (const float*)(c.ws + WS_STATS); const float* vng = (const float*)in_ptr(c, I_VNG) + li * 1024;
    const int fr = c.lane & 15, fq = c.lane >> 4;
    int wgrp = -1;
    for (int unit = c.bid; unit < 512; unit += c.G) {
        const int grp = unit & 7, nc = (unit >> 3) & 15, b = unit >> 7, tok0 = b * SEQ + nc * 128;
        __syncthreads();
        if (grp != wgrp) { wgrp = grp;
#pragma unroll
        for (int pass = 0; pass < 8; ++pass) { const int e = pass * 512 + c.tid, t = e >> 5, s4 = (e & 31) * 4;
            const f32x4 w = *(const f32x4*)(wsp + ((size_t)grp * 128 + t) * 128 + s4);
            u32x2 o; o.x = cvt_pk_bf16(s4 + 0 <= t ? w[0] : 0.f, s4 + 1 <= t ? w[1] : 0.f); o.y = cvt_pk_bf16(s4 + 2 <= t ? w[2] : 0.f, s4 + 3 <= t ? w[3] : 0.f);
            *(LAS u32x2*)(Wl + t * 272 + s4 * 2) = o; } }
        if (c.tid < 128) { const f32x4* sp = (const f32x4*)(STATS + (size_t)(tok0 + c.tid) * 32); float s1 = 0.f, s2 = 0.f;
#pragma unroll
            for (int i = 0; i < 8; ++i) { const f32x4 w = sp[i]; s1 += w[0] + w[2]; s2 += w[1] + w[3]; }
            const float mean = s1 * (1.0f / 1024.0f), var = fmaxf(s2 * (1.0f / 1024.0f) - mean * mean, 0.f);
            *(LAS f32x2*)(MR + 8 * c.tid) = (f32x2){mean, rsqrtf(var + EPS)}; }
        __syncthreads();
#pragma unroll
        for (int pass = 0; pass < 4; ++pass) { const int e = pass * 512 + c.tid, sidx = e & 127, d0 = (e >> 7) * 8;
            const u32x4 vw = *(const u32x4*)(P + (size_t)(tok0 + sidx) * ABIN + 2560 + grp * 128 + d0);
            const f32x2 mr = *(const LAS f32x2*)(MR + 8 * sidx); const f32x4 g0 = *(const f32x4*)(vng + grp * 128 + d0), g1 = *(const f32x4*)(vng + grp * 128 + d0 + 4);
            LAS bf16_t* vt = (LAS bf16_t*)Vn + d0 * 136 + sidx;
            vt[0 * 136] = f2bf((bf_lo(vw.x) - mr.x) * mr.y * g0[0]); vt[1 * 136] = f2bf((bf_hi(vw.x) - mr.x) * mr.y * g0[1]); vt[2 * 136] = f2bf((bf_lo(vw.y) - mr.x) * mr.y * g0[2]); vt[3 * 136] = f2bf((bf_hi(vw.y) - mr.x) * mr.y * g0[3]);
            vt[4 * 136] = f2bf((bf_lo(vw.z) - mr.x) * mr.y * g1[0]); vt[5 * 136] = f2bf((bf_hi(vw.z) - mr.x) * mr.y * g1[1]); vt[6 * 136] = f2bf((bf_lo(vw.w) - mr.x) * mr.y * g1[2]); vt[7 * 136] = f2bf((bf_hi(vw.w) - mr.x) * mr.y * g1[3]); }
        __syncthreads();
        f32x4 acc[8];
#pragma unroll
        for (int dt = 0; dt < 8; ++dt) acc[dt] = (f32x4){0.f, 0.f, 0.f, 0.f};
        const int nks = (c.wave >> 1) + 1;
        for (int ks = 0; ks < nks; ++ks) {
            const bf16x8 wf = *(const LAS bf16x8*)(Wl + (16 * c.wave + fr) * 272 + 64 * ks + 16 * fq);
#pragma unroll
            for (int dt = 0; dt < 8; ++dt) { const bf16x8 vf = *(const LAS bf16x8*)(Vn + (16 * dt + fr) * 272 + 64 * ks + 16 * fq); acc[dt] = __builtin_amdgcn_mfma_f32_16x16x32_bf16(vf, wf, acc[dt], 0, 0, 0); }
        }
        { const int t = 16 * c.wave + fr; const float bias = bsp[grp * 128 + t]; const size_t tok = (size_t)(tok0 + t);
#pragma unroll
          for (int dt = 0; dt < 8; ++dt) { const int d = 16 * dt + 4 * fq; const u32x2 uw = *(const u32x2*)(P + tok * ABIN + 1536 + grp * 128 + d);
              u32x2 w; w.x = cvt_pk_bf16(bf_lo(uw.x) * (acc[dt][0] + bias), bf_hi(uw.x) * (acc[dt][1] + bias)); w.y = cvt_pk_bf16(bf_lo(uw.y) * (acc[dt][2] + bias), bf_hi(uw.y) * (acc[dt][3] + bias));
              *(u32x2*)(MIX + tok * D + 1024 + grp * 128 + d) = w; } }
    }
}

typedef short s16x4 __attribute__((ext_vector_type(4)));
__device__ __forceinline__ unsigned vimg_off(unsigned t, unsigned ch) { return 256u * t + 16u * (ch ^ (((t & 3u) << 2) | ((t >> 2) & 3u))); }
__device__ __forceinline__ s16x4 vtr4(LAS unsigned char* img, int rb, int cb, int lane) {
    const unsigned q = ((unsigned)lane & 15u) >> 2, pp = (unsigned)lane & 3u;
    return __builtin_amdgcn_ds_read_tr16_b64_v4i16((LAS s16x4*)(img + vimg_off((unsigned)rb + q, 2u * (unsigned)cb + (pp >> 1)) + 8u * (pp & 1u)));
}
__device__ __forceinline__ bf16x8 cat8(s16x4 a, s16x4 b) { return (bf16x8){a[0], a[1], a[2], a[3], b[0], b[1], b[2], b[3]}; }
namespace hg2 { constexpr int QD = 0, QE = 17408, KD = 34816, KDT = 52224, VT = 70656, SBT = 89088, PART = 123904, EL = 132096, ED = 132608, SSQ = 133120; }
__device__ __forceinline__ f32x4 exp4(f32x4 x) { f32x4 r; r[0] = __expf(x[0]); r[1] = __expf(x[1]); r[2] = __expf(x[2]); r[3] = __expf(x[3]); return r; }
template <bool FULL>
__device__ __forceinline__ void hgrn_seg(const Ctx& c, int lj) {
    using namespace hg2;
    const bf16_t* P = (const bf16_t*)(c.ws + WS_PROJ); const float* LOGF = (const float*)(c.ws + WS_LOGF); bf16_t* MIX = (bf16_t*)(c.ws + WS_MIX);
    f32x4* HGL = (f32x4*)(c.ws + WS_HGL); float* HGD = (float*)(c.ws + WS_HGD);
    const float* gain = (const float*)in_ptr(c, I_CONG) + lj * 128;
    LAS unsigned char* L = c.lds;
    const int fr = c.lane & 15, fq = c.lane >> 4, k4 = c.tid & 31, tg = c.tid >> 5;
    const int tt = c.wave >> 1, vt0 = 4 * (c.wave & 1);
    const int vrow = c.tid >> 4, vch = c.tid & 15;
    const unsigned olf = (unsigned)(4 * tg) * 8192u + 16u * (unsigned)k4, oq = (unsigned)(4 * tg) * (CIN * 2u) + 8u * (unsigned)k4, ov = (unsigned)vrow * (CIN * 2u) + 16u * (unsigned)vch;
    const unsigned og = (unsigned)(16 * tt + fr) * (CIN * 2u) + (unsigned)(16 * vt0 + 4 * fq) * 2u, oo = (unsigned)(16 * tt + fr) * (D * 2u) + (unsigned)(16 * vt0 + 4 * fq) * 2u;
    for (int unit = c.bid; unit < 256; unit += c.G) {
        const int seg = unit & 3, bh = unit >> 2, b = bh >> 4, h = bh & 15;
        if (!FULL && seg == 3) continue;
        f32x4 S[8];
#pragma unroll
        for (int j = 0; j < 8; ++j) S[j] = (f32x4){0.f, 0.f, 0.f, 0.f};
        if (FULL) {
            for (int sp = 0; sp < seg; ++sp) { const f32x4 dv = *(const f32x4*)(HGD + (size_t)(bh * 3 + sp) * 128 + 16 * c.wave + 4 * fq); const f32x4* lp = HGL + ((size_t)((bh * 3 + sp) * 8 + c.wave) * 8) * 64 + c.lane;
#pragma unroll
                for (int j = 0; j < 8; ++j) S[j] = dv * S[j] + lp[j * 64]; }
        }
        __syncthreads();
        if (FULL) {
#pragma unroll
            for (int j = 0; j < 8; ++j) { u32x2 w; w.x = cvt_pk_bf16(S[j][0], S[j][1]); w.y = cvt_pk_bf16(S[j][2], S[j][3]); *(LAS u32x2*)(L + SBT + (16 * j + fr) * 272 + (16 * c.wave + 4 * fq) * 2) = w; }
        }
        f32x4 dsum = (f32x4){0.f, 0.f, 0.f, 0.f};
        const size_t tokb = (size_t)b * SEQ + seg * 512;
        f32x4 lf[4]; u32x2 qw[4]; u32x4 vw[2];
        { const char* blf = (const char*)(LOGF + tokb * 2048 + h * 128); const char* bq = (const char*)(P + tokb * CIN + h * 128);
#pragma unroll
          for (int r = 0; r < 4; ++r) { lf[r] = *(const f32x4*)(blf + olf + r * 8192u); if (FULL) qw[r] = *(const u32x2*)(bq + oq + r * (CIN * 2u)); }
#pragma unroll
          for (int i = 0; i < 2; ++i) vw[i] = *(const u32x4*)(bq + 8192 + ov + i * (32u * CIN * 2u)); }
        u32x2 ypk[4];
        for (int ch = 0; ch < 8; ++ch) {
            const size_t tokc = tokb + ch * 64;
            u32x2 gtw[4];
            if (FULL) {
#pragma unroll
                for (int j = 0; j < 4; ++j) gtw[j] = *(const u32x2*)((const char*)(P + tokc * CIN + 6144 + h * 128) + og + 32u * j); }
            f32x4 bc[4];
            { f32x4 run = (f32x4){0.f, 0.f, 0.f, 0.f};
#pragma unroll
              for (int r = 0; r < 4; ++r) { run += lf[r]; bc[r] = run; }
              *(LAS f32x4*)(L + PART + (tg * 128 + 4 * k4) * 4) = run; }
            __syncthreads();
            if (FULL && ch > 0) {
#pragma unroll
                for (int j = 0; j < 4; ++j) *(u32x2*)((char*)(MIX + (tokc - 64) * D + h * 128) + oo + 32u * j) = ypk[j]; }
            { f32x4 base = (f32x4){0.f, 0.f, 0.f, 0.f}, bmid = base, blast = base;
#pragma unroll
              for (int g = 0; g < 16; ++g) { const f32x4 pv = *(const LAS f32x4*)(L + PART + (g * 128 + 4 * k4) * 4); if (g < tg) base += pv; if (g < 8) bmid += pv; blast += pv; }
              if (tg == 0) { *(LAS f32x4*)(L + EL + 16 * k4) = exp4(blast - bmid); *(LAS f32x4*)(L + ED + 16 * k4) = exp4(blast); if (!FULL) dsum += blast; }
              f32x4 emid; if (FULL) emid = exp4(bmid);
              f32x4 kdr[4];
#pragma unroll
              for (int r = 0; r < 4; ++r) { const f32x4 bb = base + bc[r]; const f32x4 e2 = exp4(bmid - bb); const f32x4 kd = (1.0f - exp4(lf[r])) * e2; kdr[r] = kd; const int t = 4 * tg + r;
                  u32x2 w; w.x = cvt_pk_bf16(kd[0], kd[1]); w.y = cvt_pk_bf16(kd[2], kd[3]); *(LAS u32x2*)(L + KD + t * 272 + 8 * k4) = w;
                  if (FULL) { const f32x4 e1 = exp4(bb - bmid); const f32x4 qf = (f32x4){bf_lo(qw[r].x), bf_hi(qw[r].x), bf_lo(qw[r].y), bf_hi(qw[r].y)}; const f32x4 qd = qf * e1, qe = qd * emid;
                      u32x2 a; a.x = cvt_pk_bf16(qd[0], qd[1]); a.y = cvt_pk_bf16(qd[2], qd[3]); *(LAS u32x2*)(L + QD + t * 272 + 8 * k4) = a;
                      u32x2 e; e.x = cvt_pk_bf16(qe[0], qe[1]); e.y = cvt_pk_bf16(qe[2], qe[3]); *(LAS u32x2*)(L + QE + t * 272 + 8 * k4) = e; } }
#pragma unroll
              for (int q = 0; q < 4; ++q) { u32x2 w; w.x = cvt_pk_bf16(kdr[0][q], kdr[1][q]); w.y = cvt_pk_bf16(kdr[2][q], kdr[3][q]); *(LAS u32x2*)(L + KDT + (4 * k4 + q) * 144 + 8 * tg) = w; }
#pragma unroll
              for (int i = 0; i < 2; ++i) *(LAS u32x4*)(L + VT + vimg_off((unsigned)(vrow + 32 * i), (unsigned)vch)) = vw[i]; }
            __syncthreads();
            if (ch + 1 < 8) { const size_t tn = tokc + 64; const char* blf = (const char*)(LOGF + tn * 2048 + h * 128); const char* bq = (const char*)(P + tn * CIN + h * 128);
#pragma unroll
                for (int r = 0; r < 4; ++r) { lf[r] = *(const f32x4*)(blf + olf + r * 8192u); if (FULL) qw[r] = *(const u32x2*)(bq + oq + r * (CIN * 2u)); }
#pragma unroll
                for (int i = 0; i < 2; ++i) vw[i] = *(const u32x4*)(bq + 8192 + ov + i * (32u * CIN * 2u)); }
            { f32x4 U[8];
#pragma unroll
              for (int j = 0; j < 8; ++j) U[j] = (f32x4){0.f, 0.f, 0.f, 0.f};
#pragma unroll
              for (int ks = 0; ks < 2; ++ks) { bf16x8 bfv[8];
                  const bf16x8 af = *(const LAS bf16x8*)(L + KDT + (16 * c.wave + fr) * 144 + 64 * ks + 16 * fq);
#pragma unroll
                  for (int j = 0; j < 8; ++j) bfv[j] = cat8(vtr4(L + VT, 32 * ks + 8 * fq, j, c.lane), vtr4(L + VT, 32 * ks + 8 * fq + 4, j, c.lane));
#pragma unroll
                  for (int j = 0; j < 8; ++j) U[j] = __builtin_amdgcn_mfma_f32_16x16x32_bf16(af, bfv[j], U[j], 0, 0, 0); }
              const f32x4 ed = *(const LAS f32x4*)(L + ED + (16 * c.wave + 4 * fq) * 4), el = *(const LAS f32x4*)(L + EL + (16 * c.wave + 4 * fq) * 4);
#pragma unroll
              for (int j = 0; j < 8; ++j) S[j] = ed * S[j] + el * U[j]; }
            f32x4 o[4];
            if (FULL) {
                f32x4 sc[4];
                { bf16x8 qdf[4];
#pragma unroll
                  for (int ks = 0; ks < 4; ++ks) qdf[ks] = *(const LAS bf16x8*)(L + QD + (16 * tt + fr) * 272 + 64 * ks + 16 * fq);
#pragma unroll
                  for (int st = 0; st < 4; ++st) { sc[st] = (f32x4){0.f, 0.f, 0.f, 0.f};
                    if (st <= tt) { bf16x8 kdf[4];
#pragma unroll
                        for (int ks = 0; ks < 4; ++ks) kdf[ks] = *(const LAS bf16x8*)(L + KD + (16 * st + fr) * 272 + 64 * ks + 16 * fq);
#pragma unroll
                        for (int ks = 0; ks < 4; ++ks) sc[st] = __builtin_amdgcn_mfma_f32_16x16x32_bf16(kdf[ks], qdf[ks], sc[st], 0, 0, 0);
                        if (st == tt) {
#pragma unroll
                            for (int q = 0; q < 4; ++q) sc[st][q] = (4 * fq + q <= fr) ? sc[st][q] : 0.f; } } } }
                const bf16x8 pf0 = pack8(sc[0], sc[1]), pf1 = pack8(sc[2], sc[3]);
#pragma unroll
                for (int j = 0; j < 4; ++j) o[j] = (f32x4){0.f, 0.f, 0.f, 0.f};
#pragma unroll
                for (int ks = 0; ks < 4; ++ks) { bf16x8 sbf[4]; const bf16x8 qef = *(const LAS bf16x8*)(L + QE + (16 * tt + fr) * 272 + 64 * ks + 16 * fq);
#pragma unroll
                    for (int j = 0; j < 4; ++j) sbf[j] = *(const LAS bf16x8*)(L + SBT + (16 * (vt0 + j) + fr) * 272 + 64 * ks + 16 * fq);
                    __builtin_amdgcn_sched_barrier(0);
#pragma unroll
                    for (int j = 0; j < 4; ++j) o[j] = __builtin_amdgcn_mfma_f32_16x16x32_bf16(sbf[j], qef, o[j], 0, 0, 0);
                    __builtin_amdgcn_sched_barrier(0); }
#pragma unroll
                for (int u = 0; u < 2; ++u) { if (2 * u <= tt) { bf16x8 vf[4];
#pragma unroll
                    for (int j = 0; j < 4; ++j) vf[j] = cat8(vtr4(L + VT, 32 * u + 4 * fq, vt0 + j, c.lane), vtr4(L + VT, 32 * u + 16 + 4 * fq, vt0 + j, c.lane));
#pragma unroll
                    for (int j = 0; j < 4; ++j) o[j] = __builtin_amdgcn_mfma_f32_16x16x32_bf16(vf[j], u == 0 ? pf0 : pf1, o[j], 0, 0, 0); } }
            }
            if (FULL) {
                { f32x4 sq = (f32x4){0.f, 0.f, 0.f, 0.f};
#pragma unroll
                  for (int j = 0; j < 4; ++j) sq += o[j] * o[j];
                  float x = (sq[0] + sq[1]) + (sq[2] + sq[3]); x += sx<16>(x); x = sum_x32(x);
                  if (fq == 0) ((LAS float*)(L + SSQ))[c.wave * 16 + fr] = x; }
                __syncthreads();
#pragma unroll
                for (int j = 0; j < 8; ++j) { u32x2 w; w.x = cvt_pk_bf16(S[j][0], S[j][1]); w.y = cvt_pk_bf16(S[j][2], S[j][3]); *(LAS u32x2*)(L + SBT + (16 * j + fr) * 272 + (16 * c.wave + 4 * fq) * 2) = w; }
                const float rstd = rsqrtf((((const LAS float*)(L + SSQ))[c.wave * 16 + fr] + ((const LAS float*)(L + SSQ))[(c.wave ^ 1) * 16 + fr]) * (1.0f / 128.0f) + EPS);
#pragma unroll
                for (int j = 0; j < 4; ++j) { const f32x4 gn = *(const f32x4*)(gain + 16 * (vt0 + j) + 4 * fq); const f32x4 gt = (f32x4){bf_lo(gtw[j].x), bf_hi(gtw[j].x), bf_lo(gtw[j].y), bf_hi(gtw[j].y)};
                    const f32x4 y = o[j] * rstd * gn * gt; ypk[j].x = cvt_pk_bf16(y[0], y[1]); ypk[j].y = cvt_pk_bf16(y[2], y[3]); }
            }
        }
        if (FULL) {
#pragma unroll
            for (int j = 0; j < 4; ++j) *(u32x2*)((char*)(MIX + (tokb + 7 * 64) * D + h * 128) + oo + 32u * j) = ypk[j]; }
        if (!FULL) {
            f32x4* lp = HGL + ((size_t)((bh * 3 + seg) * 8 + c.wave) * 8) * 64 + c.lane;
#pragma unroll
            for (int j = 0; j < 8; ++j) lp[j * 64] = S[j];
            if (tg == 0) *(f32x4*)(HGD + (size_t)(bh * 3 + seg) * 128 + 4 * k4) = exp4(dsum);
        }
    }
}

constexpr int PH_PER_LAYER = 9, PH_FINAL = 1 + DEPTH * PH_PER_LAYER, N_PHASES = PH_FINAL + 1;
template <int KIND, bool DRY = false>
__device__ __forceinline__ void run_phase(const Ctx& c0, int l) {
    Ctx c = c0; { unsigned long long w = (unsigned long long)c.ws; asm volatile("" : "+s"(w)); c.ws = (unsigned char*)w; int t = c.wave * 64 + my_lane(); asm volatile("" : "+v"(t)); c.tid = t; c.lane = t & 63; }
    const int li = l >> 1; const bool odd = (l & 1) != 0;
    const int vcu = (c.G % 8 == 0) ? (c.bid % 8) * (c.G / 8) + c.bid / 8 : c.bid;
    if constexpr (KIND == 0) { p0_ada(c); __syncthreads(); p0_convert(c); p0_lb(c); }
    if constexpr (KIND == 1) norm_phase<0, DRY>(c, l);
    if constexpr (KIND == 2) { pg8::Gemm g{(const bf16_t*)(c.ws + WS_H), (const bf16_t*)(c.ws + WS_WABIN) + (size_t)li * ABIN * D, T, ABIN, D}; pg8::StaticOrder S; S.init(T, ABIN, c.G, c.bid);
        pg8::EpiProjA E{(bf16_t*)(c.ws + WS_PROJ), (float*)(c.ws + WS_STATS)}; pg8::gemm_phase<pg8::EpiProjA, pg8::StaticOrder>(c.lds, g, S, E, c.tid); }
    if constexpr (KIND == 3) { pg8::Gemm g{(const bf16_t*)(c.ws + WS_H), (const bf16_t*)(c.ws + WS_WCIN) + (size_t)li * CIN * D, T, CIN, D}; pg8::StaticOrder S; S.init(T, CIN, c.G, c.bid);
        pg8::EpiProjC E{(bf16_t*)(c.ws + WS_PROJ), (float*)(c.ws + WS_LOGF), (const float*)(c.ws + WS_LB) + l * D}; pg8::gemm_phase<pg8::EpiProjC, pg8::StaticOrder>(c.lds, g, S, E, c.tid); }
    if constexpr (KIND == 5) { attn_mfma(c, li); gating_mfma(c, li); }
    if constexpr (KIND == 6) hgrn_seg<true>(c, li);
    if constexpr (KIND == 13) hgrn_seg<false>(c, li);
    if constexpr (KIND == 7) {
        const bf16_t* Bt = odd ? (const bf16_t*)(c.ws + WS_WCOUT) + (size_t)li * D * D : (const bf16_t*)(c.ws + WS_WABOUT) + (size_t)li * D * D;
        pg8::Gemm g{(const bf16_t*)(c.ws + WS_MIX), Bt, T, D, D}; pg8::StaticOrder S; S.init(T, D, c.G, c.bid);
        float* xr = (l == 0) ? (float*)in_ptr(c, I_X) : (float*)in_ptr(c, 24);
        pg8::EpiResid E{xr, (const float*)(c.ws + WS_MOD) + (size_t)l * 4 * 12288 + 2 * D, (long)((DRY ? (float*)(c.ws + WS_PROJ) : (float*)in_ptr(c, 24)) - xr)}; pg8::gemm_phase<pg8::EpiResid, pg8::StaticOrder>(c.lds, g, S, E, c.tid); }
    if constexpr (KIND == 8) norm_phase<1, DRY>(c, l);
    if constexpr (KIND == 10) { LAS int* pb = (LAS int*)(c.lds + MISC_OFF) + 16; moe_tables(c, l, pb);
        pg8::Gemm g{(const bf16_t*)(c.ws + WS_ASORT), (const bf16_t*)(c.ws + WS_WGU), 0, 0, D}; pg8::MoeOrder S{pb, 4, c.G, vcu, l * 16 * 4, 128, 32};
        pg8::EpiMoe1 E{(bf16_t*)(c.ws + WS_HID), (const float*)(c.ws + WS_GW)}; pg8::gemm_phase<pg8::EpiMoe1, pg8::MoeOrder>(c.lds, g, S, E, c.tid); if (l + 1 < DEPTH) { const int U = pb[16] * 4, rounds = (U + c.G - 1) / c.G, busy = U - (rounds - 1) * c.G; __syncthreads(); moe_conv_tail(c, l + 1, 0, vcu >= busy ? vcu - busy : -1, c.G - busy > 0 ? c.G - busy : 1); if (busy >= c.G) moe_conv_tail(c, l + 1, 0, vcu, c.G); } }
    if constexpr (KIND == 11) { LAS int* pb = (LAS int*)(c.lds + MISC_OFF) + 16; moe_tables(c, l, pb);
        pg8::Gemm g{(const bf16_t*)(c.ws + WS_HID), (const bf16_t*)(c.ws + WS_WDN), 0, 0, DE}; pg8::MoeOrder S{pb, 8, c.G, vcu, l * 16 * 8, 256, 0};
        pg8::EpiMoe2 E{(bf16_t*)(c.ws + WS_Y)}; pg8::gemm_phase<pg8::EpiMoe2, pg8::MoeOrder>(c.lds, g, S, E, c.tid); if (l + 1 < DEPTH) { const int U = pb[16] * 8, rounds = (U + c.G - 1) / c.G, busy = U - (rounds - 1) * c.G; __syncthreads(); moe_conv_tail(c, l + 1, 1, vcu >= busy ? vcu - busy : -1, c.G - busy > 0 ? c.G - busy : 1); if (busy >= c.G) moe_conv_tail(c, l + 1, 1, vcu, c.G); } }
    if constexpr (KIND == 12) norm_phase<2, DRY>(c, 0);
}
__device__ __forceinline__ Ctx make_ctx(const Args& a, unsigned char* lds_raw) {
    Ctx c; c.lds = (LAS unsigned char*)lds_raw; c.tid = threadIdx.x; c.lane = c.tid & 63; c.wave = __builtin_amdgcn_readfirstlane(c.tid >> 6); c.G = gridDim.x; c.bid = blockIdx.x; c.ws = a.ws;
    if (c.tid < 25) ((LAS unsigned long long*)(c.lds + INP_OFF))[c.tid] = (c.tid < 24) ? (unsigned long long)a.in[c.tid] : (unsigned long long)a.out;
    __syncthreads();
    return c;
}
__global__ void __launch_bounds__(512, 2) mega(Args a) {
    extern __shared__ __attribute__((aligned(16))) unsigned char lds_raw[];
    const Ctx c = make_ctx(a, lds_raw);
    volatile LAS unsigned* MISC = (volatile LAS unsigned*)(c.lds + MISC_OFF);
    if (c.tid < 16) MISC[c.tid] = 0u;
    __syncthreads();
    XcdBarrier bar = xcd_barrier_post((unsigned*)(c.ws + WS_CTL) + CW_BAR, MISC + 8, c.wave);
#define RP(k, l) do { run_phase<k>(c, l); xcd_barrier(bar, c.wave); if ((PROBE_DUP >> k) & 1) { run_phase<k, true>(c, l); xcd_barrier(bar, c.wave); } } while (0)
    RP(0, 0);
#define LAYER_EVEN(l) do { RP(1, l); RP(2, l); RP(5, l); RP(7, l); RP(8, l); RP(10, l); RP(11, l); } while (0)
#define LAYER_ODD(l) do { RP(1, l); RP(3, l); RP(13, l); RP(6, l); RP(7, l); RP(8, l); RP(10, l); RP(11, l); } while (0)
    LAYER_EVEN(0); LAYER_ODD(1); LAYER_EVEN(2); LAYER_ODD(3);
    run_phase<12>(c, 0);
    if ((PROBE_DUP >> 12) & 1) { xcd_barrier(bar, c.wave); run_phase<12, true>(c, 0); }
}

extern "C" void kernel_launch(void* const* d_in, const int* in_sizes, int n_in, void* d_out, int out_size, void* d_ws, size_t ws_size, hipStream_t stream) {
    static int grid = 0;
    if (grid == 0) {
        if (n_in != 24 || out_size != T * D || ws_size < WS_END) { fprintf(stderr, "kernel_launch: unexpected shapes: n_in %d out %d ws %zu (need %zu)\n", n_in, out_size, ws_size, (size_t)WS_END); grid = -1; return; }
        int dev = 0, cus = 0;
        if (hipGetDevice(&dev) != hipSuccess || hipDeviceGetAttribute(&cus, hipDeviceAttributeMultiprocessorCount, dev) != hipSuccess) { grid = -1; return; }
        int per_cu = 0;
        if (hipFuncSetAttribute((const void*)mega, hipFuncAttributeMaxDynamicSharedMemorySize, LDS_BYTES) != hipSuccess) { fprintf(stderr, "kernel_launch: hipFuncSetAttribute failed\n"); grid = -1; return; }
        if (hipOccupancyMaxActiveBlocksPerMultiprocessor(&per_cu, (const void*)mega, 512, LDS_BYTES) != hipSuccess || per_cu < 1) fprintf(stderr, "kernel_launch: occupancy query reports %d\n", per_cu);
        (void)hipGetLastError();
        grid = cus;
    }
    if (grid < 0) return;
    (void)hipMemsetAsync((char*)d_ws + WS_CTL, 0, CTL_ZERO_BYTES, stream);
    Args a{};
    for (int i = 0; i < 24; ++i) a.in[i] = d_in[i];
    a.out = (float*)d_out; a.ws = (unsigned char*)d_ws;
    hipLaunchKernelGGL(mega, dim3(grid), dim3(512), LDS_BYTES, stream, a);
}
```

```cpp
#include <hip/hip_runtime.h>
#include <cstdio>
#include <cstdint>


#ifndef PROBE_DUP
#define PROBE_DUP 0
#endif
#define LAS __attribute__((address_space(3)))
#define GAS __attribute__((address_space(1)))
typedef unsigned short bf16_t;
typedef short bf16x8 __attribute__((ext_vector_type(8)));
typedef float f32x4 __attribute__((ext_vector_type(4)));
typedef float f32x2 __attribute__((ext_vector_type(2)));
typedef unsigned u32x4 __attribute__((ext_vector_type(4)));
typedef unsigned u32x2 __attribute__((ext_vector_type(2)));

constexpr int D = 2048, NBATCH = 4, SEQ = 2048, T = NBATCH * SEQ, DEPTH = 4;
constexpr int ABIN = 3584, CIN = 8192, NE = 16, DE = 512;
constexpr float EPS = 1e-6f;

constexpr size_t MiB = 1u << 20;
constexpr size_t WS_CTL = 0, CTL_ZERO_BYTES = 1 * MiB;
constexpr size_t WS_MOD = 1 * MiB;
constexpr size_t WS_LB = 2 * MiB;
constexpr size_t WS_WABIN = 4 * MiB;
constexpr size_t WS_WABOUT = WS_WABIN + 28 * MiB;
constexpr size_t WS_WCIN = WS_WABOUT + 16 * MiB;
constexpr size_t WS_WCOUT = WS_WCIN + 64 * MiB;
constexpr size_t WS_WGU = WS_WCOUT + 16 * MiB;
constexpr size_t WS_WDN = WS_WGU + 256 * MiB;
constexpr size_t WS_H = WS_WDN + 128 * MiB;
constexpr size_t WS_PROJ = WS_H + 32 * MiB;
constexpr size_t WS_LOGF = WS_PROJ + 128 * MiB;
constexpr size_t WS_MIX = WS_LOGF + 64 * MiB;
constexpr size_t WS_MOE = WS_MIX + 32 * MiB;
constexpr size_t WS_LIST = WS_MOE, WS_GW = WS_MOE + 512 * 1024, WS_TOKINFO = WS_MOE + 1024 * 1024;
constexpr size_t WS_HID = WS_MOE + 2 * MiB;
constexpr size_t WS_Y = WS_HID + 20 * MiB;
constexpr size_t WS_ASORT = WS_Y + 80 * MiB;
constexpr size_t WS_STATS = WS_ASORT + 512 * MiB;
constexpr size_t WS_HGL = WS_STATS + 1 * MiB;
constexpr size_t WS_HGD = WS_HGL + 12 * MiB;
constexpr size_t WS_END = WS_HGD + 1 * MiB;
constexpr int CW_BAR = 4096;
constexpr int CW_QHEAD = 12288;
constexpr int CW_CNT = 16384;

constexpr int LDS_BYTES = 147456;
constexpr int MISC_OFF = LDS_BYTES - 1024;

typedef __bf16 bf16x2_t __attribute__((ext_vector_type(2)));
__device__ __forceinline__ unsigned cvt_pk_bf16(float lo, float hi) { return __builtin_bit_cast(unsigned, __builtin_convertvector((f32x2){lo, hi}, bf16x2_t)); }
__device__ __forceinline__ float bf_lo(unsigned w) { return __uint_as_float(w << 16); }
__device__ __forceinline__ float bf_hi(unsigned w) { return __uint_as_float(w & 0xffff0000u); }
__device__ __forceinline__ float bf2f(bf16_t b) { return __uint_as_float(((unsigned)b) << 16); }
__device__ __forceinline__ bf16_t f2bf(float f) { return (bf16_t)(cvt_pk_bf16(f, 0.f) & 0xffffu); }
template <int O> __device__ __forceinline__ float sx(float v) { static_assert(O > 0 && O < 32, "ds_swizzle xor within 32 lanes"); return __int_as_float(__builtin_amdgcn_ds_swizzle(__float_as_int(v), (O << 10) | 0x1f)); }
__device__ __forceinline__ float sum_x32(float v) { const unsigned x = (unsigned)__float_as_int(v); const auto r = __builtin_amdgcn_permlane32_swap(x, x, false, false); return __int_as_float((int)r[0]) + __int_as_float((int)r[1]); }
__device__ __forceinline__ float get_x32(float v, bool upper) { const unsigned x = (unsigned)__float_as_int(v); const auto r = __builtin_amdgcn_permlane32_swap(x, x, false, false); return __int_as_float((int)(upper ? r[0] : r[1])); }
template <int CTRL> __device__ __forceinline__ float dppf(float v) { return __int_as_float(__builtin_amdgcn_update_dpp(0, __float_as_int(v), CTRL, 0xF, 0xF, true)); }
__device__ __forceinline__ float x1(float v) { return dppf<0xB1>(v); }
__device__ __forceinline__ float x2(float v) { return dppf<0x4E>(v); }
__device__ __forceinline__ float x8(float v) { return dppf<0x128>(v); }
__device__ __forceinline__ float rr4(float v) { return dppf<0x124>(v); }
__device__ __forceinline__ float hm8(float v) { return dppf<0x141>(v); }
__device__ __forceinline__ float x4(float v, int lane) { const float a = dppf<0x114>(v), b = dppf<0x104>(v); return (lane & 4) ? a : b; }
__device__ __forceinline__ float sum_x16(float v) { const unsigned x = (unsigned)__float_as_int(v); const auto r = __builtin_amdgcn_permlane16_swap(x, x, false, false); return __int_as_float((int)r[0]) + __int_as_float((int)r[1]); }
__device__ __forceinline__ float max_x16(float v) { const unsigned x = (unsigned)__float_as_int(v); const auto r = __builtin_amdgcn_permlane16_swap(x, x, false, false); return fmaxf(__int_as_float((int)r[0]), __int_as_float((int)r[1])); }
__device__ __forceinline__ float get_x16(float v, bool upper) { const unsigned x = (unsigned)__float_as_int(v); const auto r = __builtin_amdgcn_permlane16_swap(x, x, false, false); return __int_as_float((int)(upper ? r[0] : r[1])); }
__device__ __forceinline__ float wave_sum(float v) { v += x1(v); v += x2(v); v += rr4(v); v += x8(v); v = sum_x16(v); return sum_x32(v); }
__device__ __forceinline__ float fast_exp(float x) { return __builtin_amdgcn_exp2f(x * 1.4426950408889634f); }
__device__ __forceinline__ float sigmoidf_(float x) { return __builtin_amdgcn_rcpf(1.0f + fast_exp(-x)); }
__device__ __forceinline__ float gelu_tanh(float x) { const float z = 1.5957691216057308f * (x + 0.044715f * x * x * x); return x * sigmoidf_(z); }

#define XB_TMO      128
#define XB_XCNT(j)  (256  + 64 * (j))
#define XB_XSUB(j)  (1280 + 64 * (j))
#define XB_XGEN(j)  (2304 + 64 * (j))
#define XB_TOP      3328
#define XB_TOPGEN   3392
#define XCD_BAR_WORDS 3456
#define XB_SPIN_CAP (1u << 18)
__device__ __forceinline__ unsigned xb_ld(unsigned* p)              { return __hip_atomic_load(p, __ATOMIC_RELAXED, __HIP_MEMORY_SCOPE_AGENT); }
__device__ __forceinline__ unsigned xb_add(unsigned* p, unsigned v) { return __hip_atomic_fetch_add(p, v, __ATOMIC_RELAXED, __HIP_MEMORY_SCOPE_AGENT); }
__device__ __forceinline__ unsigned xb_xcc_id() { return (unsigned)__builtin_amdgcn_s_getreg((3 << 11) | 20) & 0xFu; }
#define XB_SPIN(cond, bar) do { unsigned _sp = 0; while (cond) { __builtin_amdgcn_s_sleep(1); \
    if ((++_sp & 255u) == 0u) { if (xb_ld(&(bar)[XB_TMO])) break; if (_sp > XB_SPIN_CAP) { atomicAdd(&(bar)[XB_TMO], 1u); break; } } } } while (0)
struct XcdBarrier { unsigned* bar; unsigned x; volatile LAS unsigned* st; };
__device__ __forceinline__ int my_lane() { int l; asm volatile("v_mbcnt_lo_u32_b32 %0, -1, 0\n\tv_mbcnt_hi_u32_b32 %0, -1, %0" : "=v"(l)); return l; }
__device__ __forceinline__ XcdBarrier xcd_barrier_post(unsigned* bar, volatile LAS unsigned* st, int wave) {
    XcdBarrier b; b.bar = bar; b.x = xb_xcc_id(); b.st = st;
    if (wave == 0 && my_lane() == 0) (void)xb_add(&bar[XB_XCNT(b.x)], 1u);
    return b;
}
__device__ __forceinline__ void xcd_barrier_complete(unsigned* bar, unsigned x, unsigned& nloc, unsigned& nx) {
    const unsigned G = gridDim.x * gridDim.y * gridDim.z;
    unsigned sum, cnt, mine, sp = 0u;
    for (;;) {
        sum = 0u; cnt = 0u; mine = 0u;
#pragma unroll
        for (unsigned j = 0; j < 16; ++j) { const unsigned c = xb_ld(&bar[XB_XCNT(j)]); sum += c; cnt += (c > 0u) ? 1u : 0u; mine = (j == x) ? c : mine; }
        if (sum == G) break;
        __builtin_amdgcn_s_sleep(1);
        if ((++sp & 255u) == 0u) { if (xb_ld(&bar[XB_TMO])) break; if (sp > XB_SPIN_CAP) { atomicAdd(&bar[XB_TMO], 1u); break; } }
    }
    nloc = mine > 0u ? mine : 1u; nx = cnt > 0u ? cnt : 1u;
}
__device__ __forceinline__ void xcd_barrier(const XcdBarrier& b, int wave) {
    asm volatile("s_waitcnt vmcnt(0)" ::: "memory");
    __syncthreads();
    if (wave == 0 && my_lane() == 0) {
        unsigned* bar = b.bar;
        __builtin_amdgcn_s_waitcnt(0);
        unsigned nloc = b.st[0], nx = b.st[1];
        if (nloc == 0u) { xcd_barrier_complete(bar, b.x, nloc, nx); b.st[0] = nloc; b.st[1] = nx; }
        const unsigned old = xb_add(&bar[XB_XSUB(b.x)], 1u);
        const unsigned gen = old / nloc;
        if (old + 1u == (gen + 1u) * nloc) {
            __builtin_amdgcn_fence(__ATOMIC_RELEASE, "agent");
            asm volatile("s_waitcnt vmcnt(0)" ::: "memory");
            const unsigned og = xb_add(&bar[XB_TOP], 1u);
            const unsigned tg = og / nx;
            if (og + 1u == (tg + 1u) * nx) xb_add(&bar[XB_TOPGEN], 1u);
            else XB_SPIN(xb_ld(&bar[XB_TOPGEN]) == tg, bar);
            __builtin_amdgcn_fence(__ATOMIC_ACQUIRE, "agent");
            xb_add(&bar[XB_XGEN(b.x)], 1u);
            asm volatile("s_waitcnt vmcnt(0)" ::: "memory");
        } else {
            XB_SPIN(xb_ld(&bar[XB_XGEN(b.x)]) == gen, bar);
            __builtin_amdgcn_fence(__ATOMIC_ACQUIRE, "agent");
            asm volatile("s_waitcnt vmcnt(0)" ::: "memory");
        }
    }
    __syncthreads();
}

namespace pg8 {
constexpr int BM = 256, BK = 64, HALF = 128, HTB = HALF * BK * 2, STAGE_BYTES = 8 * HTB, NXCD = 8, WGM = 4;
__host__ __device__ __forceinline__ int lds_byte(int r, int c) { const int st = (r >> 4) * 2 + (c >> 5), rr = r & 15, cc = c & 31, ob = rr * 64 + cc * 2; return st * 1024 + (ob ^ (((ob >> 9) & 1) << 5)); }
__host__ __device__ __forceinline__ void stage_rc(int b, int& R, int& C) { const int st = b / 1024, sb = b % 1024, swz = sb ^ (((sb >> 9) & 1) << 5); R = (st >> 1) * 16 + swz / 64; C = (st & 1) * 32 + (swz % 64) / 2; }
__host__ __device__ __forceinline__ int perm32(int rho) { const int n = rho >> 4, i = rho & 15; return 8 * (i >> 2) + 4 * n + (i & 3); }

struct Unit { int pm, pn, orow, ocol, aux, nvalid; };
struct Gemm { const bf16_t* A; const bf16_t* Bt; int M, N, K; };

struct StaticOrder {
    int nM, nN, nwg, G, c;
    __device__ __forceinline__ const int* rows(const Unit&) const { return nullptr; }
    __device__ void init(int M, int N, int G_, int c_) { nM = M / BM; nN = N / BM; nwg = nM * nN; G = G_; c = c_; }
    __device__ bool next(int i, Unit& u) const {
        const long L = (long)i * G + c; if (L >= nwg) return false;
        int wgid = (int)L; { const int q = nwg / NXCD, r = nwg % NXCD, xcd = wgid % NXCD, off = wgid / NXCD; wgid = (xcd < r ? xcd * (q + 1) : r * (q + 1) + (xcd - r) * q) + off; }
        const int nig = WGM * nN, gid = wgid / nig, fm = gid * WGM, gsz = (nM - fm) < WGM ? (nM - fm) : WGM;
        u.pm = fm + ((wgid % nig) % gsz); u.pn = (wgid % nig) / gsz; u.orow = u.pm * BM; u.ocol = u.pn * BM; u.aux = 0; u.nvalid = 256; return true;
    }
};
struct MoeOrder {
    const LAS int* pb; int NJ, G, c, tbase, colw, acap; const int* list;
    __device__ __forceinline__ const int* rows(const Unit& u) const { return list + u.aux; }
    __device__ bool next(int i, Unit& u) const {
        const int L = i * G + c; const int P = L / NJ, j = L - P * NJ; const int NP = pb[16]; if (P >= NP) return false;
        int e = 0;
#pragma unroll
        for (int k = 1; k < 16; ++k) e += (P >= pb[k]) ? 1 : 0;
        const int p = P - pb[e];
        u.pm = __builtin_amdgcn_readfirstlane(acap ? e * acap + p : P); u.pn = __builtin_amdgcn_readfirstlane(tbase + e * NJ + j); u.orow = __builtin_amdgcn_readfirstlane(P * 256); u.ocol = __builtin_amdgcn_readfirstlane(j * colw);
        u.aux = __builtin_amdgcn_readfirstlane(e * 8192 + p * 256); u.nvalid = __builtin_amdgcn_readfirstlane(pb[17 + e] - p * 256); return true;
    }
};

struct EpiProjA {
    static constexpr bool PERM = true, AFTER_DRAIN = false;
    bf16_t* O; float* STATS;
    __device__ __forceinline__ void operator()(const f32x4 (&acc)[2][2][4][2], const Unit& u, int wr, int wc, int fr, int fq) const {
        const int row0 = u.orow + wr * 64 + fr, col0 = u.ocol + wc * 32 + 8 * fq; const bool act = u.ocol >= 1536, st = u.ocol >= 2560;
#pragma unroll
        for (int ai = 0; ai < 2; ++ai)
#pragma unroll
            for (int m = 0; m < 4; ++m) { bf16_t* rowp = O + (size_t)(row0 + ai * HALF + m * 16) * ABIN + col0; float s1 = 0.f, s2 = 0.f;
#pragma unroll
                for (int bj = 0; bj < 2; ++bj) { f32x4 v0 = acc[ai][bj][m][0], v1 = acc[ai][bj][m][1];
                    if (act) {
#pragma unroll
                        for (int q = 0; q < 4; ++q) { v0[q] = gelu_tanh(v0[q]); v1[q] = gelu_tanh(v1[q]); } }
                    u32x4 w; w.x = cvt_pk_bf16(v0[0], v0[1]); w.y = cvt_pk_bf16(v0[2], v0[3]); w.z = cvt_pk_bf16(v1[0], v1[1]); w.w = cvt_pk_bf16(v1[2], v1[3]);
                    *(u32x4*)(rowp + bj * HALF) = w;
                    if (st) { const float a0 = bf_lo(w.x), a1 = bf_hi(w.x), a2 = bf_lo(w.y), a3 = bf_hi(w.y), a4 = bf_lo(w.z), a5 = bf_hi(w.z), a6 = bf_lo(w.w), a7 = bf_hi(w.w);
                        s1 += ((a0 + a1) + (a2 + a3)) + ((a4 + a5) + (a6 + a7)); s2 += ((a0 * a0 + a1 * a1) + (a2 * a2 + a3 * a3)) + ((a4 * a4 + a5 * a5) + (a6 * a6 + a7 * a7)); } }
                if (st) { s1 = sum_x16(s1); s1 = sum_x32(s1); s2 = sum_x16(s2); s2 = sum_x32(s2);
                    if (fq == 0) *(f32x2*)(STATS + ((size_t)(row0 + ai * HALF + m * 16) * 16 + ((u.ocol - 2560) >> 8) * 4 + wc) * 2) = (f32x2){s1, s2}; } }
    }
};
struct EpiProjC {
    static constexpr bool PERM = true, AFTER_DRAIN = false;
    bf16_t* O; float* LOGF; const float* lb;
    __device__ __forceinline__ void operator()(const f32x4 (&acc)[2][2][4][2], const Unit& u, int wr, int wc, int fr, int fq) const {
        const int row0 = u.orow + wr * 64 + fr, col0 = u.ocol + wc * 32 + 8 * fq; const int mode = u.ocol >> 11;
        if (mode == 1) {
#pragma unroll
            for (int bj = 0; bj < 2; ++bj) { const int k0 = col0 - 2048 + bj * HALF; const f32x4 l0 = *(const f32x4*)(lb + k0), l1 = *(const f32x4*)(lb + k0 + 4);
#pragma unroll
                for (int ai = 0; ai < 2; ++ai)
#pragma unroll
                    for (int m = 0; m < 4; ++m) { float* rowp = LOGF + (size_t)(row0 + ai * HALF + m * 16) * 2048 + k0; f32x4 v0 = acc[ai][bj][m][0], v1 = acc[ai][bj][m][1];
#pragma unroll
                        for (int q = 0; q < 4; ++q) { v0[q] = __logf(l0[q] + (1.0f - l0[q]) * sigmoidf_(v0[q])); v1[q] = __logf(l1[q] + (1.0f - l1[q]) * sigmoidf_(v1[q])); }
                        *(f32x4*)rowp = v0; *(f32x4*)(rowp + 4) = v1; } }
        } else {
#pragma unroll
            for (int ai = 0; ai < 2; ++ai)
#pragma unroll
                for (int m = 0; m < 4; ++m) { bf16_t* rowp = O + (size_t)(row0 + ai * HALF + m * 16) * CIN + col0;
#pragma unroll
                    for (int bj = 0; bj < 2; ++bj) { f32x4 v0 = acc[ai][bj][m][0], v1 = acc[ai][bj][m][1];
                        if (mode == 3) {
#pragma unroll
                            for (int q = 0; q < 4; ++q) { v0[q] = v0[q] * sigmoidf_(v0[q]); v1[q] = v1[q] * sigmoidf_(v1[q]); } }
                        u32x4 w; w.x = cvt_pk_bf16(v0[0], v0[1]); w.y = cvt_pk_bf16(v0[2], v0[3]); w.z = cvt_pk_bf16(v1[0], v1[1]); w.w = cvt_pk_bf16(v1[2], v1[3]);
                        *(u32x4*)(rowp + bj * HALF) = w; } }
        }
    }
};
struct EpiResid {
    static constexpr bool PERM = false, AFTER_DRAIN = false;
    float* X; const float* gate; long wofs;
    __device__ __forceinline__ void operator()(const f32x4 (&acc)[2][2][4][2], const Unit& u, int wr, int wc, int fr, int fq) const {
        const int row0 = u.orow + wr * 64 + fr, col0 = u.ocol + wc * 32 + 4 * fq; const int b = u.orow >> 11;
        f32x4 gv[2][2];
#pragma unroll
        for (int bj = 0; bj < 2; ++bj)
#pragma unroll
            for (int n = 0; n < 2; ++n) gv[bj][n] = *(const f32x4*)(gate + (size_t)b * 12288 + col0 + bj * HALF + n * 16);
#pragma unroll
        for (int ai = 0; ai < 2; ++ai)
#pragma unroll
            for (int m = 0; m < 4; ++m) { float* rowp = X + (size_t)(row0 + ai * HALF + m * 16) * D + col0;
#pragma unroll
                for (int bj = 0; bj < 2; ++bj)
#pragma unroll
                    for (int n = 0; n < 2; ++n) { f32x4* p = (f32x4*)(rowp + bj * HALF + n * 16); *(f32x4*)((float*)p + wofs) = *p + gv[bj][n] * acc[ai][bj][m][n]; } }
    }
};
struct EpiMoe1 {
    static constexpr bool PERM = true, AFTER_DRAIN = false;
    bf16_t* HID; const float* GW;
    __device__ __forceinline__ void operator()(const f32x4 (&acc)[2][2][4][2], const Unit& u, int wr, int wc, int fr, int fq) const {
        const int col0 = u.ocol + wc * 32 + 8 * fq;
#pragma unroll
        for (int ai = 0; ai < 2; ++ai)
#pragma unroll
            for (int m = 0; m < 4; ++m) { const int r = ai * HALF + wr * 64 + m * 16 + fr; const float gw = (r < u.nvalid) ? GW[u.aux + r] : 0.f;
                f32x4 a0 = acc[ai][0][m][0], a1 = acc[ai][0][m][1]; const f32x4 u0 = acc[ai][1][m][0], u1 = acc[ai][1][m][1];
#pragma unroll
                for (int q = 0; q < 4; ++q) { a0[q] = a0[q] * sigmoidf_(a0[q]) * u0[q] * gw; a1[q] = a1[q] * sigmoidf_(a1[q]) * u1[q] * gw; }
                u32x4 w; w.x = cvt_pk_bf16(a0[0], a0[1]); w.y = cvt_pk_bf16(a0[2], a0[3]); w.z = cvt_pk_bf16(a1[0], a1[1]); w.w = cvt_pk_bf16(a1[2], a1[3]);
                *(u32x4*)(HID + (size_t)(u.orow + r) * DE + col0) = w; }
    }
};
struct EpiMoe2 {
    static constexpr bool PERM = true, AFTER_DRAIN = false;
    bf16_t* Y;
    __device__ __forceinline__ void operator()(const f32x4 (&acc)[2][2][4][2], const Unit& u, int wr, int wc, int fr, int fq) const {
        const int row0 = u.orow + wr * 64 + fr, col0 = u.ocol + wc * 32 + 8 * fq;
#pragma unroll
        for (int ai = 0; ai < 2; ++ai)
#pragma unroll
            for (int m = 0; m < 4; ++m) { bf16_t* rowp = Y + (size_t)(row0 + ai * HALF + m * 16) * D + col0;
#pragma unroll
                for (int bj = 0; bj < 2; ++bj) { const f32x4 v0 = acc[ai][bj][m][0], v1 = acc[ai][bj][m][1];
                    u32x4 w; w.x = cvt_pk_bf16(v0[0], v0[1]); w.y = cvt_pk_bf16(v0[2], v0[3]); w.z = cvt_pk_bf16(v1[0], v1[1]); w.w = cvt_pk_bf16(v1[2], v1[3]);
                    *(u32x4*)(rowp + bj * HALF) = w; } }
    }
};

template <class Epi, class Sched, bool ALIGN_EPI = true, bool SP2 = true, bool GATHER = false>
__device__ __forceinline__ void gemm_phase(LAS unsigned char* lds, const Gemm g, const Sched& S, const Epi& E, const int tid) {
    static_assert(!GATHER || SP2, "the gathered A operand is wired into the SP2 loop only");
    const int wid = __builtin_amdgcn_readfirstlane(tid >> 6), lane = tid & 63, wr = wid >> 2, wc = wid & 3, fr = lane & 15, fq = lane >> 4;
    const int K = g.K, nt = K / BK;
    unsigned voffA[2], voffB[2];
#pragma unroll
    for (int i = 0; i < 2; ++i) { int R, C; stage_rc(tid * 16 + i * 8192, R, C); const int Rb = Epi::PERM ? ((R & ~31) + perm32(R & 31)) : R;
        voffA[i] = (unsigned)(R * K + C) * 2u; voffB[i] = (unsigned)(Rb * K + C) * 2u; }
    const size_t kstep = (size_t)(BK * 2);
    const size_t hstep = (size_t)HALF * K * 2;
    const size_t tstep = 2 * hstep;
    const unsigned ldsw = (unsigned)wid * 1024u;
    const int aoff = lds_byte(wr * 64 + fr, fq * 8), boff = lds_byte(wc * 32 + fr, fq * 8);
#define PG8_SA(b, h) (((b) * 2 + (h)) * HTB)
#define PG8_SB(b, h) ((4 + (b) * 2 + (h)) * HTB)
#define PG8_STAGE(bufoff, gbase, voff) do { _Pragma("unroll") for (int _i = 0; _i < 2; ++_i) \
        __builtin_amdgcn_global_load_lds((const unsigned*)((const char*)(gbase) + (voff)[_i]), (LAS unsigned*)(lds + (bufoff) + ldsw + _i * 8192), 16, 0, 0); } while (0)
    unsigned vGc[2][2], vGn[2][2];
#define PG8_ROWS(u, v) do { const int* _rl = S.rows(u); _Pragma("unroll") for (int _h = 0; _h < 2; ++_h) _Pragma("unroll") for (int _i = 0; _i < 2; ++_i) { int _R, _C; stage_rc(tid * 16 + _i * 8192, _R, _C); \
        const int _r = _h * HALF + _R; const int _idx = _rl[_r < (u).nvalid ? _r : 0]; (v)[_h][_i] = (unsigned)(_idx * K + _C) * 2u; } } while (0)
#define PG8_STAGE_A(bufoff, kb, h, nx) do { if constexpr (GATHER) { _Pragma("unroll") for (int _i = 0; _i < 2; ++_i) \
        __builtin_amdgcn_global_load_lds((const unsigned*)((const char*)(kb) + ((nx) ? vGn[h][_i] : vGc[h][_i])), (LAS unsigned*)(lds + (bufoff) + ldsw + _i * 8192), 16, 0, 0); } \
        else PG8_STAGE(bufoff, (kb) + (h) * hstep, voffA); } while (0)
#define PG8_LDA(dst, b, h) do { _Pragma("unroll") for (int m = 0; m < 4; ++m) _Pragma("unroll") for (int k = 0; k < 2; ++k) dst[m][k] = *(const LAS bf16x8*)(lds + PG8_SA(b, h) + aoff + m * 2048 + k * 1024); } while (0)
#define PG8_LDB(dst, b, h) do { _Pragma("unroll") for (int n = 0; n < 2; ++n) _Pragma("unroll") for (int k = 0; k < 2; ++k) dst[n][k] = *(const LAS bf16x8*)(lds + PG8_SB(b, h) + boff + n * 2048 + k * 1024); } while (0)
#define PG8_MMA(ai, bj, At, Bt) do { __builtin_amdgcn_s_setprio(1); _Pragma("unroll") for (int m = 0; m < 4; ++m) _Pragma("unroll") for (int n = 0; n < 2; ++n) _Pragma("unroll") for (int k = 0; k < 2; ++k) \
        acc[ai][bj][m][n] = __builtin_amdgcn_mfma_f32_16x16x32_bf16(Bt[n][k], At[m][k], acc[ai][bj][m][n], 0, 0, 0); __builtin_amdgcn_s_setprio(0); } while (0)
#define PG8_WAIT_V(n) asm volatile("s_waitcnt vmcnt(" #n ")" ::: "memory")
#define PG8_WAIT_L(n) asm volatile("s_waitcnt lgkmcnt(" #n ")" ::: "memory")
#define PG8_BAR __builtin_amdgcn_s_barrier()
#define PG8_SCHED __builtin_amdgcn_sched_barrier(0)
    Unit cur, nxt; int ui = 0;
    if (!S.next(0, cur)) return;
    f32x4 acc[2][2][4][2];
#pragma unroll
    for (int a = 0; a < 2; ++a)
#pragma unroll
        for (int b = 0; b < 2; ++b)
#pragma unroll
            for (int m = 0; m < 4; ++m)
#pragma unroll
                for (int n = 0; n < 2; ++n) acc[a][b][m][n] = (f32x4){0.f, 0.f, 0.f, 0.f};
    bf16x8 At[4][2], B0[2][2], B1[2][2];
    const char* cA = (const char*)g.A + (GATHER ? (size_t)0 : (size_t)cur.pm * tstep); const char* cB = (const char*)g.Bt + (size_t)cur.pn * tstep;
    if constexpr (GATHER) PG8_ROWS(cur, vGc);
    if constexpr (SP2) {
        PG8_STAGE(PG8_SB(0, 0), cB, voffB); PG8_STAGE(PG8_SB(0, 1), cB + hstep, voffB); PG8_STAGE_A(PG8_SA(0, 0), cA, 0, false); PG8_STAGE_A(PG8_SA(0, 1), cA, 1, false);
        if (wr == 1) PG8_BAR;
        PG8_WAIT_V(2); PG8_BAR;
        PG8_STAGE(PG8_SB(1, 0), cB + kstep, voffB); PG8_STAGE_A(PG8_SA(1, 0), cA + kstep, 0, false); PG8_STAGE(PG8_SB(1, 1), cB + hstep + kstep, voffB);
        PG8_WAIT_V(6); PG8_BAR;
    } else {
        PG8_STAGE(PG8_SB(0, 0), cB, voffB); PG8_STAGE(PG8_SA(0, 0), cA, voffA); PG8_STAGE(PG8_SB(0, 1), cB + hstep, voffB); PG8_STAGE(PG8_SA(0, 1), cA + hstep, voffA);
        if (wr == 1) PG8_BAR;
        PG8_WAIT_V(4); PG8_BAR;
        PG8_STAGE(PG8_SB(1, 0), cB + kstep, voffB); PG8_STAGE(PG8_SA(1, 0), cA + kstep, voffA); PG8_STAGE(PG8_SB(1, 1), cB + hstep + kstep, voffB);
        PG8_WAIT_V(6); PG8_BAR;
    }
    for (;;) {
        const bool has_next = S.next(ui + 1, nxt);
        const char* nA = GATHER ? cA : (has_next ? (const char*)g.A + (size_t)nxt.pm * tstep : cA); const char* nB = has_next ? (const char*)g.Bt + (size_t)nxt.pn * tstep : cB;
        if constexpr (GATHER) { if (has_next) PG8_ROWS(nxt, vGn); else {
_Pragma("unroll") for (int _h = 0; _h < 2; ++_h) _Pragma("unroll") for (int _i = 0; _i < 2; ++_i) vGn[_h][_i] = vGc[_h][_i]; } }
        for (int t = 0; t < nt; t += 2) {
            const bool last = (t == nt - 2);
            const char* a1 = cA + (size_t)(t + 1) * kstep;
            const char* a2 = last ? nA : cA + (size_t)(t + 2) * kstep; const char* b2 = last ? nB : cB + (size_t)(t + 2) * kstep;
            const char* a3 = a2 + kstep; const char* b3 = b2 + kstep;
            if constexpr (SP2) {
            PG8_LDB(B0, 0, 0); PG8_LDB(B1, 0, 1); PG8_SCHED; PG8_LDA(At, 0, 0); PG8_STAGE_A(PG8_SA(1, 1), a1, 1, false);
            PG8_WAIT_V(8); PG8_WAIT_L(0); PG8_BAR; PG8_MMA(0, 0, At, B0); PG8_MMA(0, 1, At, B1); PG8_BAR; PG8_SCHED;
            PG8_LDA(At, 0, 1); PG8_STAGE(PG8_SB(0, 0), b2, voffB); PG8_STAGE(PG8_SB(0, 1), b2 + hstep, voffB); PG8_STAGE_A(PG8_SA(0, 0), a2, 0, last);
            PG8_WAIT_V(8); PG8_WAIT_L(0); PG8_BAR; PG8_MMA(1, 0, At, B0); PG8_MMA(1, 1, At, B1); PG8_BAR; PG8_SCHED;
            PG8_LDB(B0, 1, 0); PG8_LDB(B1, 1, 1); PG8_SCHED; PG8_LDA(At, 1, 0); PG8_STAGE_A(PG8_SA(0, 1), a2, 1, last);
            PG8_WAIT_V(8); PG8_WAIT_L(0); PG8_BAR; PG8_MMA(0, 0, At, B0); PG8_MMA(0, 1, At, B1); PG8_BAR; PG8_SCHED;
            PG8_LDA(At, 1, 1); PG8_STAGE(PG8_SB(1, 0), b3, voffB); PG8_STAGE(PG8_SB(1, 1), b3 + hstep, voffB); PG8_STAGE_A(PG8_SA(1, 0), a3, 0, last);
            PG8_WAIT_V(8); PG8_WAIT_L(0); PG8_BAR; PG8_MMA(1, 0, At, B0); PG8_MMA(1, 1, At, B1); PG8_BAR; PG8_SCHED;
            } else {
            PG8_LDB(B0, 0, 0); PG8_SCHED; PG8_LDA(At, 0, 0); PG8_STAGE(PG8_SA(1, 1), a1 + hstep, voffA);
            PG8_WAIT_L(8); PG8_BAR; PG8_WAIT_L(0); PG8_MMA(0, 0, At, B0); PG8_BAR; PG8_SCHED;
            PG8_LDB(B1, 0, 1); PG8_STAGE(PG8_SB(0, 0), b2, voffB);
            PG8_BAR; PG8_WAIT_L(0); PG8_MMA(0, 1, At, B1); PG8_BAR;
            PG8_LDA(At, 0, 1); PG8_STAGE(PG8_SA(0, 0), a2, voffA);
            PG8_BAR; PG8_WAIT_L(0); PG8_MMA(1, 0, At, B0); PG8_BAR; PG8_SCHED;
            PG8_STAGE(PG8_SB(0, 1), b2 + hstep, voffB);
            PG8_WAIT_V(6); PG8_BAR; PG8_MMA(1, 1, At, B1); PG8_BAR;
            PG8_LDB(B0, 1, 0); PG8_SCHED; PG8_LDA(At, 1, 0); PG8_STAGE(PG8_SA(0, 1), a2 + hstep, voffA);
            PG8_WAIT_L(8); PG8_BAR; PG8_WAIT_L(0); PG8_MMA(0, 0, At, B0); PG8_BAR; PG8_SCHED;
            PG8_LDB(B1, 1, 1); PG8_STAGE(PG8_SB(1, 0), b3, voffB);
            PG8_BAR; PG8_WAIT_L(0); PG8_MMA(0, 1, At, B1); PG8_BAR;
            PG8_LDA(At, 1, 1); PG8_STAGE(PG8_SA(1, 0), a3, voffA);
            PG8_BAR; PG8_WAIT_L(0); PG8_MMA(1, 0, At, B0); PG8_BAR; PG8_SCHED;
            PG8_STAGE(PG8_SB(1, 1), b3 + hstep, voffB);
            PG8_WAIT_V(6); PG8_BAR; PG8_MMA(1, 1, At, B1); PG8_BAR;
            }
        }
        if constexpr (ALIGN_EPI) { if (wr == 0) PG8_BAR; }
        E(acc, cur, wr, wc, fr, fq);
        if (!has_next) break;
#pragma unroll
        for (int a = 0; a < 2; ++a)
#pragma unroll
            for (int b = 0; b < 2; ++b)
#pragma unroll
                for (int m = 0; m < 4; ++m)
#pragma unroll
                    for (int n = 0; n < 2; ++n) acc[a][b][m][n] = (f32x4){0.f, 0.f, 0.f, 0.f};
        cur = nxt; cA = nA; cB = nB; ++ui;
        if constexpr (GATHER) {
_Pragma("unroll") for (int _h = 0; _h < 2; ++_h) _Pragma("unroll") for (int _i = 0; _i < 2; ++_i) vGc[_h][_i] = vGn[_h][_i]; }
        if constexpr (ALIGN_EPI) { if (wr == 1) PG8_BAR; }
    }
    PG8_WAIT_V(0);
    if constexpr (!ALIGN_EPI) { if (wr == 0) PG8_BAR; }
    PG8_BAR;
#undef PG8_SA
#undef PG8_SB
#undef PG8_STAGE
#undef PG8_STAGE_A
#undef PG8_ROWS
#undef PG8_LDA
#undef PG8_LDB
#undef PG8_MMA
#undef PG8_WAIT_V
#undef PG8_WAIT_L
#undef PG8_BAR
#undef PG8_SCHED
}
}

struct Args { const void* in[24]; float* out; unsigned char* ws; };
enum { I_X = 0, I_C, I_POS, I_ADAW, I_ADAB, I_N1G, I_N2G, I_ABWIN, I_QNG, I_KNG, I_SINKS, I_VNG, I_GMWS, I_GMB, I_ABWOUT, I_CWIN, I_CLB, I_CONG, I_CWOUT, I_RW, I_RB, I_WG, I_WU, I_WD };

struct Ctx { int tid, lane, wave, G, bid; LAS unsigned char* lds; unsigned char* ws; };
constexpr int INP_OFF = MISC_OFF + 512;
__device__ __forceinline__ const void* in_ptr(const Ctx& c, int i) {
    const unsigned long long v = ((const LAS unsigned long long*)(c.lds + INP_OFF))[i];
    return (const void*)(((unsigned long long)(unsigned)__builtin_amdgcn_readfirstlane((int)(unsigned)(v >> 32)) << 32) | (unsigned long long)(unsigned)__builtin_amdgcn_readfirstlane((int)(unsigned)v));
}

__device__ __forceinline__ void p0_ada(const Ctx& c) {
    LAS float* cond = (LAS float*)c.lds;
    LAS float* red = (LAS float*)(c.lds + 32768);
    const float* cin = (const float*)in_ptr(c, I_C); const float* adaw = (const float*)in_ptr(c, I_ADAW); const float* adab = (const float*)in_ptr(c, I_ADAB);
    float* MOD = (float*)(c.ws + WS_MOD);
    for (int i = c.tid; i < NBATCH * D; i += 512) { const float v = cin[i]; cond[i] = v * sigmoidf_(v); }
    __syncthreads();
    for (int u = c.bid; u < 256; u += c.G) {
        const int col0 = u * 192, l = col0 / 12288, j0 = col0 % 12288;
        const float* W = adaw + (size_t)l * D * 12288 + j0;
        f32x4 acc[4];
#pragma unroll
        for (int b = 0; b < 4; ++b) acc[b] = (f32x4){0.f, 0.f, 0.f, 0.f};
        if (c.lane < 48) {
            for (int k = c.wave; k < D; k += 128) {
                f32x4 w[16];
#pragma unroll
                for (int r = 0; r < 16; ++r) w[r] = __builtin_nontemporal_load((const f32x4*)(W + (size_t)(k + 8 * r) * 12288 + 4 * c.lane));
#pragma unroll
                for (int r = 0; r < 16; ++r)
#pragma unroll
                    for (int b = 0; b < 4; ++b) acc[b] += w[r] * cond[b * D + k + 8 * r];
            }
#pragma unroll
            for (int b = 0; b < 4; ++b) *(LAS f32x4*)(red + ((c.wave * 4 + b) * 192 + 4 * c.lane)) = acc[b];
        }
        __syncthreads();
        for (int o = c.tid; o < 768; o += 512) { const int b = o / 192, jj = o % 192; float s = 0.f;
#pragma unroll
            for (int w = 0; w < 8; ++w) s += red[(w * 4 + b) * 192 + jj];
            MOD[(size_t)(l * 4 + b) * 12288 + j0 + jj] = s + adab[l * 12288 + j0 + jj]; }
        __syncthreads();
    }
}
__device__ __forceinline__ void p0_tr_item(const float* W, int K, int N, bf16_t* WT, int item, int kind, LAS float* scr, int lane) {
    const int nblk = N >> 6, kb = item / nblk, nb = item - kb * nblk, k0 = 64 * kb, n0 = 64 * nb;
    f32x4 v[16];
#pragma unroll
    for (int i = 0; i < 16; ++i) { const int kk = 4 * i + (lane >> 4); v[i] = __builtin_nontemporal_load((const f32x4*)(W + (size_t)(k0 + kk) * N + n0 + 4 * (lane & 15))); }
#pragma unroll
    for (int i = 0; i < 16; ++i) { const int kk = 4 * i + (lane >> 4); LAS float* p = scr + kk * 65 + 4 * (lane & 15); p[0] = v[i][0]; p[1] = v[i][1]; p[2] = v[i][2]; p[3] = v[i][3]; }
    asm volatile("s_waitcnt lgkmcnt(0)" ::: "memory");
    int drow0 = n0;
    if (kind == 1) drow0 = 256 * (n0 >> 7) + (n0 & 127);
    if (kind == 2) drow0 = 256 * (n0 >> 7) + 128 + (n0 & 127);
    const int cc = lane & 7;
#pragma unroll
    for (int jj = 0; jj < 8; ++jj) { const int n = (lane >> 3) + 8 * jj; const LAS float* s = scr + (8 * cc) * 65 + n;
        u32x4 o; o.x = cvt_pk_bf16(s[0 * 65], s[1 * 65]); o.y = cvt_pk_bf16(s[2 * 65], s[3 * 65]); o.z = cvt_pk_bf16(s[4 * 65], s[5 * 65]); o.w = cvt_pk_bf16(s[6 * 65], s[7 * 65]);
        __builtin_nontemporal_store(o, (u32x4*)(WT + (size_t)(drow0 + n) * K + k0 + 8 * cc)); }
    asm volatile("s_waitcnt lgkmcnt(0)" ::: "memory");
}
__device__ __forceinline__ void p0_convert(const Ctx& c) {
    LAS float* scr = (LAS float*)(c.lds + c.wave * 16640);
    const int gw = c.bid * 8 + c.wave, NGW = c.G * 8;
    constexpr int I_ABI = 32 * 56, I_SQ = 32 * 32, I_CI = 32 * 128, I_DENSE = 2 * (I_ABI + I_SQ + I_CI + I_SQ), I_MOE = 16 * 768;
    for (int it = gw; it < I_DENSE + I_MOE; it += NGW) {
        int r = it;
        if (r < I_DENSE) {
            const int i = r / (I_ABI + I_SQ + I_CI + I_SQ); r -= i * (I_ABI + I_SQ + I_CI + I_SQ);
            if (r < I_ABI) { p0_tr_item((const float*)in_ptr(c, I_ABWIN) + (size_t)i * D * ABIN, D, ABIN, (bf16_t*)(c.ws + WS_WABIN) + (size_t)i * ABIN * D, r, 0, scr, c.lane); continue; } r -= I_ABI;
            if (r < I_SQ) { p0_tr_item((const float*)in_ptr(c, I_ABWOUT) + (size_t)i * D * D, D, D, (bf16_t*)(c.ws + WS_WABOUT) + (size_t)i * D * D, r, 0, scr, c.lane); continue; } r -= I_SQ;
            if (r < I_CI) { p0_tr_item((const float*)in_ptr(c, I_CWIN) + (size_t)i * D * CIN, D, CIN, (bf16_t*)(c.ws + WS_WCIN) + (size_t)i * CIN * D, r, 0, scr, c.lane); continue; } r -= I_CI;
            p0_tr_item((const float*)in_ptr(c, I_CWOUT) + (size_t)i * D * D, D, D, (bf16_t*)(c.ws + WS_WCOUT) + (size_t)i * D * D, r, 0, scr, c.lane);
        } else {
            r -= I_DENSE; const int le = r / 768, q = r - le * 768, which = q >> 8, item = q & 255;
            if (which == 0) p0_tr_item((const float*)in_ptr(c, I_WG) + (size_t)le * D * DE, D, DE, (bf16_t*)(c.ws + WS_WGU) + (size_t)le * 1024 * D, item, 1, scr, c.lane);
            else if (which == 1) p0_tr_item((const float*)in_ptr(c, I_WU) + (size_t)le * D * DE, D, DE, (bf16_t*)(c.ws + WS_WGU) + (size_t)le * 1024 * D, item, 2, scr, c.lane);
            else p0_tr_item((const float*)in_ptr(c, I_WD) + (size_t)le * DE * D, DE, D, (bf16_t*)(c.ws + WS_WDN) + (size_t)le * D * DE, item, 0, scr, c.lane);
        }
    }
}
__device__ __forceinline__ void moe_conv_tail(const Ctx& c, int L, int which, int rank, int nidle) {
    if (rank < 0) return;
    LAS float* scr = (LAS float*)(c.lds + c.wave * 16640);
    const int n = which == 0 ? 8192 : 4096;
    for (int it = rank * 8 + c.wave; it < n; it += nidle * 8) {
        if (which == 0) { const int le = L * 16 + (it >> 9), q = it & 511;
            if (q < 256) p0_tr_item((const float*)in_ptr(c, I_WG) + (size_t)le * D * DE, D, DE, (bf16_t*)(c.ws + WS_WGU) + (size_t)le * 1024 * D, q, 1, scr, c.lane);
            else p0_tr_item((const float*)in_ptr(c, I_WU) + (size_t)le * D * DE, D, DE, (bf16_t*)(c.ws + WS_WGU) + (size_t)le * 1024 * D, q - 256, 2, scr, c.lane); }
        else { const int le = L * 16 + (it >> 8);
            p0_tr_item((const float*)in_ptr(c, I_WD) + (size_t)le * DE * D, DE, D, (bf16_t*)(c.ws + WS_WDN) + (size_t)le * D * DE, it & 255, 0, scr, c.lane); }
    }
}
__device__ __forceinline__ void p0_lb(const Ctx& c) {
    if (c.bid != 0) return;
    const float* clb = (const float*)in_ptr(c, I_CLB); float* LB = (float*)(c.ws + WS_LB);
    for (int k = c.tid; k < D; k += 512) {
        const float v0 = clb[k], v1 = clb[D + k], v2 = clb[2 * D + k], v3 = clb[3 * D + k];
        const float m = fmaxf(fmaxf(v0, v1), fmaxf(v2, v3));
        const float e0 = __expf(v0 - m), e1 = __expf(v1 - m), e2 = __expf(v2 - m), e3 = __expf(v3 - m); const float inv = 1.0f / (e0 + e1 + e2 + e3);
        LB[k] = 0.f; LB[D + k] = e1 * inv; LB[2 * D + k] = (e1 + e2) * inv; LB[3 * D + k] = (e1 + e2 + e3) * inv;
    }
}

__device__ __forceinline__ void moe_tables(const Ctx& c, int l, LAS int* pb) {
    __syncthreads();
    if (c.tid == 0) { const unsigned* cnt = (const unsigned*)(c.ws + WS_CTL) + CW_CNT + l * 16 * 64; int acc = 0;
        for (int e = 0; e < NE; ++e) { const int n = (int)cnt[e * 64]; pb[e] = acc; pb[17 + e] = n; acc += (n + 255) >> 8; }
        pb[16] = acc; }
    __syncthreads();
}

__device__ __forceinline__ float treduce32(const float (&p)[32], int lane) {
    float a16[16], a8[8], a4[4], a2[2], a1;
    { const bool up = (lane & 32) != 0;
#pragma unroll
      for (int j = 0; j < 16; ++j) { const float send = up ? p[j] : p[j + 16]; a16[j] = (up ? p[j + 16] : p[j]) + get_x32(send, up); } }
    { const bool up = (lane & 16) != 0;
#pragma unroll
      for (int j = 0; j < 8; ++j) { const float send = up ? a16[j] : a16[j + 8]; a8[j] = (up ? a16[j + 8] : a16[j]) + get_x16(send, up); } }
    { const bool up = (lane & 8) != 0;
#pragma unroll
      for (int j = 0; j < 4; ++j) { const float send = up ? a8[j] : a8[j + 4]; a4[j] = (up ? a8[j + 4] : a8[j]) + x8(send); } }
    { const bool up = (lane & 4) != 0;
#pragma unroll
      for (int j = 0; j < 2; ++j) { const float send = up ? a4[j] : a4[j + 2]; a2[j] = (up ? a4[j + 2] : a4[j]) + x4(send, lane); } }
    { const bool up = (lane & 2) != 0; const float send = up ? a2[0] : a2[1]; a1 = (up ? a2[1] : a2[0]) + x2(send); }
    return a1 + x1(a1);
}
__device__ __forceinline__ float treduce16(const float (&p)[16], int lane) {
    float r8[8], r4[4], r2[2], r1;
    { const bool up = (lane & 32) != 0;
#pragma unroll
      for (int j = 0; j < 8; ++j) { const float send = up ? p[j] : p[j + 8]; r8[j] = (up ? p[j + 8] : p[j]) + get_x32(send, up); } }
    { const bool up = (lane & 16) != 0;
#pragma unroll
      for (int j = 0; j < 4; ++j) { const float send = up ? r8[j] : r8[j + 4]; r4[j] = (up ? r8[j + 4] : r8[j]) + get_x16(send, up); } }
    { const bool up = (lane & 8) != 0;
#pragma unroll
      for (int j = 0; j < 2; ++j) { const float send = up ? r4[j] : r4[j + 2]; r2[j] = (up ? r4[j + 2] : r4[j]) + x8(send); } }
    { const bool up = (lane & 4) != 0; const float send = up ? r2[0] : r2[1]; r1 = (up ? r2[1] : r2[0]) + x4(send, lane); }
    r1 += x2(r1); r1 += x1(r1);
    return r1;
}
namespace ns { constexpr int PARTS = 0, RSTD = 1024, RA = 1280, RB = 1408, RPART = 2048, LOGIT = 18432, SEL = 20480; }
template <int MODE, bool DRY = false>
__device__ __forceinline__ void norm_phase(const Ctx& c, int l) {
    using namespace ns;
    constexpr int R = 32;
    float* X = (float*)in_ptr(c, 24); const float* xin = (const float*)in_ptr(c, I_X);
    float* Xw = DRY ? (float*)(c.ws + WS_PROJ) : X;
    bf16_t* H = (bf16_t*)(c.ws + (DRY ? WS_LOGF : WS_H)); const bf16_t* Y = (const bf16_t*)(c.ws + WS_Y);
    const float* MOD = (const float*)(c.ws + WS_MOD);
    LAS unsigned char* L = c.lds;
    LAS int* pb = (LAS int*)(c.lds + MISC_OFF) + 16;
    const bool combine = (MODE == 2) || (MODE == 0 && l > 0);
    const int lp = (MODE == 2) ? DEPTH - 1 : l - 1;
    if (combine) moe_tables(c, lp, pb);
    const int col = 256 * c.wave + 4 * c.lane;
    const int* tokinfo = (const int*)(c.ws + WS_TOKINFO);
    f32x4 rwv[4][4];
    if (MODE == 1) { const float* rwg = (const float*)in_ptr(c, I_RW);
#pragma unroll
        for (int q = 0; q < 4; ++q)
#pragma unroll
            for (int e4 = 0; e4 < 4; ++e4) rwv[q][e4] = *(const f32x4*)(rwg + (size_t)(col + q) * 16 + 4 * e4); }
    const int vcu = (c.G % 8 == 0) ? (c.bid % 8) * (c.G / 8) + c.bid / 8 : c.bid;
    for (int grp = vcu; grp < T / R; grp += c.G) {
        const int row0 = grp * R, b = row0 >> 11;
        __syncthreads();
        if (combine && c.tid < R) { const int ia = tokinfo[(row0 + c.tid) * 2], ib = tokinfo[(row0 + c.tid) * 2 + 1];
            ((LAS int*)(L + RA))[c.tid] = pb[ia >> 16] * 256 + (ia & 0xffff); ((LAS int*)(L + RB))[c.tid] = pb[ib >> 16] * 256 + (ib & 0xffff); }
        f32x4 xv[R];
        { const float* xs = ((MODE == 0 && l == 0) ? xin : X) + (size_t)row0 * D + col;
#pragma unroll
          for (int r = 0; r < R; ++r) xv[r] = *(const f32x4*)(xs + (size_t)r * D); }
        if (combine) {
            __syncthreads();
            const f32x4 g2 = *(const f32x4*)(MOD + (size_t)(lp * 4 + b) * 12288 + 5 * D + col);
#pragma unroll
            for (int r = 0; r < R; ++r) { const int ra = ((const LAS int*)(L + RA))[r], rb = ((const LAS int*)(L + RB))[r];
                const u32x2 wa = *(const u32x2*)(Y + (size_t)ra * D + col), wb = *(const u32x2*)(Y + (size_t)rb * D + col);
                xv[r][0] += g2[0] * (bf_lo(wa.x) + bf_lo(wb.x)); xv[r][1] += g2[1] * (bf_hi(wa.x) + bf_hi(wb.x)); xv[r][2] += g2[2] * (bf_lo(wa.y) + bf_lo(wb.y)); xv[r][3] += g2[3] * (bf_hi(wa.y) + bf_hi(wb.y)); }
        }
        if (MODE == 2 || (MODE == 0 && l > 0)) {
#pragma unroll
            for (int r = 0; r < R; ++r) *(f32x4*)(Xw + (size_t)(row0 + r) * D + col) = xv[r];
        }
        if (MODE == 2) continue;
        { float ps[R];
#pragma unroll
          for (int r = 0; r < R; ++r) ps[r] = (xv[r][0] * xv[r][0] + xv[r][1] * xv[r][1]) + (xv[r][2] * xv[r][2] + xv[r][3] * xv[r][3]);
          const float tot = treduce32(ps, c.lane); if ((c.lane & 1) == 0) ((LAS float*)(L + PARTS))[c.wave * 32 + (c.lane >> 1)] = tot; }
        __syncthreads();
        if (c.tid < R) { float s = 0.f;
#pragma unroll
            for (int w = 0; w < 8; ++w) s += ((const LAS float*)(L + PARTS))[w * 32 + c.tid];
            ((LAS float*)(L + RSTD))[c.tid] = rsqrtf(s * (1.0f / D) + EPS); }
        __syncthreads();
        const float* ng = (const float*)in_ptr(c, MODE == 0 ? I_N1G : I_N2G) + l * D; const float* sh = MOD + (size_t)(l * 4 + b) * 12288 + (MODE == 0 ? 0 : 3 * D);
        const f32x4 A = *(const f32x4*)(ng + col) * (*(const f32x4*)(sh + D + col) + 1.0f), B = *(const f32x4*)(sh + col);
        if (MODE == 0) {
#pragma unroll
            for (int r = 0; r < R; ++r) xv[r] = xv[r] * (A * ((const LAS float*)(L + RSTD))[r]) + B; }
        if (MODE == 0) {
#pragma unroll
            for (int r = 0; r < R; ++r) { u32x2 w; w.x = cvt_pk_bf16(xv[r][0], xv[r][1]); w.y = cvt_pk_bf16(xv[r][2], xv[r][3]); *(u32x2*)(H + (size_t)(row0 + r) * D + col) = w; }
            continue;
        }
        u32x2 hpk[R];
#pragma unroll
        for (int r = 0; r < R; ++r) { const f32x4 hv = xv[r] * (A * ((const LAS float*)(L + RSTD))[r]) + B; float p[16];
#pragma unroll
            for (int e4 = 0; e4 < 4; ++e4) { const f32x4 a = rwv[0][e4] * hv[0] + rwv[1][e4] * hv[1] + rwv[2][e4] * hv[2] + rwv[3][e4] * hv[3]; p[4 * e4] = a[0]; p[4 * e4 + 1] = a[1]; p[4 * e4 + 2] = a[2]; p[4 * e4 + 3] = a[3]; }
            const float tot = treduce16(p, c.lane);
            if ((c.lane & 3) == 0) ((LAS float*)(L + RPART))[(c.wave * R + r) * 16 + (c.lane >> 2)] = tot;
            hpk[r].x = cvt_pk_bf16(hv[0], hv[1]); hpk[r].y = cvt_pk_bf16(hv[2], hv[3]); }
        __syncthreads();
        if (c.tid < R * 16) { float lg = 0.f;
#pragma unroll
          for (int w = 0; w < 8; ++w) lg += ((const LAS float*)(L + RPART))[w * (R * 16) + c.tid];
          ((LAS float*)(L + LOGIT))[c.tid] = lg; }
        __syncthreads();
        if (c.tid < R) {
            const float* rb = (const float*)in_ptr(c, I_RB); const int row = row0 + c.tid;
            float sc16[16], sel[16];
#pragma unroll
            for (int e4 = 0; e4 < 4; ++e4) { const f32x4 lg = *(const LAS f32x4*)(L + LOGIT + (c.tid * 16 + 4 * e4) * 4);
#pragma unroll
                for (int q = 0; q < 4; ++q) { sc16[4 * e4 + q] = 1.0f / (1.0f + __expf(-lg[q])); sel[4 * e4 + q] = sc16[4 * e4 + q] + rb[4 * e4 + q]; } }
            float bestg = -1e30f; int be1 = 0, be2 = 0; float bs1 = 0.f, bs2 = 0.f;
#pragma unroll
            for (int g = 0; g < 4; ++g) {
                int e1 = 4 * g; float s1 = sel[4 * g], w1 = sc16[4 * g];
#pragma unroll
                for (int k = 1; k < 4; ++k) if (sel[4 * g + k] > s1) { s1 = sel[4 * g + k]; w1 = sc16[4 * g + k]; e1 = 4 * g + k; }
                int e2 = -1; float s2 = -1e30f, w2 = 0.f;
#pragma unroll
                for (int k = 0; k < 4; ++k) if ((4 * g + k) != e1 && sel[4 * g + k] > s2) { s2 = sel[4 * g + k]; w2 = sc16[4 * g + k]; e2 = 4 * g + k; }
                const float gs = s1 + s2;
                if (gs > bestg) { bestg = gs; be1 = e1; be2 = e2; bs1 = w1; bs2 = w2; }
            }
            unsigned* cnt = (unsigned*)(c.ws + WS_CTL) + CW_CNT + (DRY ? 4 + l : l) * 16 * 64;
            const unsigned sa = __hip_atomic_fetch_add(cnt + be1 * 64, 1u, __ATOMIC_RELAXED, __HIP_MEMORY_SCOPE_AGENT) + (DRY ? 4096u : 0u);
            const unsigned sb = __hip_atomic_fetch_add(cnt + be2 * 64, 1u, __ATOMIC_RELAXED, __HIP_MEMORY_SCOPE_AGENT) + (DRY ? 4096u : 0u);
            const float inv = 1.0f / (bs1 + bs2);
            float* gwp = (float*)(c.ws + WS_GW); int* ti = (int*)(c.ws + (DRY ? WS_STATS : WS_TOKINFO)); int* lst = (int*)(c.ws + WS_LIST);
            gwp[be1 * 8192 + sa] = bs1 * inv; gwp[be2 * 8192 + sb] = bs2 * inv; lst[be1 * 8192 + sa] = row; lst[be2 * 8192 + sb] = row;
            ti[row * 2] = (be1 << 16) | (int)sa; ti[row * 2 + 1] = (be2 << 16) | (int)sb;
        }
        { bf16_t* Hh = (bf16_t*)(c.ws + (DRY ? WS_LOGF : WS_H));
#pragma unroll
          for (int r = 0; r < R; ++r) *(u32x2*)(Hh + (size_t)(row0 + r) * D + col) = hpk[r]; }
    }
}
__device__ __forceinline__ bf16x8 pack8(f32x4 a, f32x4 b) { u32x4 w; w.x = cvt_pk_bf16(a[0], a[1]); w.y = cvt_pk_bf16(a[2], a[3]); w.z = cvt_pk_bf16(b[0], b[1]); w.w = cvt_pk_bf16(b[2], b[3]); return __builtin_bit_cast(bf16x8, w); }
__device__ __forceinline__ float max_x32(float v) { const unsigned x = (unsigned)__float_as_int(v); const auto r = __builtin_amdgcn_permlane32_swap(x, x, false, false); return fmaxf(__int_as_float((int)r[0]), __int_as_float((int)r[1])); }
__device__ __forceinline__ void attn_mfma(const Ctx& c, int li) {
    const bf16_t* P = (const bf16_t*)(c.ws + WS_PROJ); bf16_t* MIX = (bf16_t*)(c.ws + WS_MIX);
    const float* sinks = (const float*)in_ptr(c, I_SINKS) + li * 16;
    const int* pos = (const int*)in_ptr(c, I_POS); const float* qg = (const float*)in_ptr(c, I_QNG) + li * 64; const float* kg = (const float*)in_ptr(c, I_KNG) + li * 64;
    LAS unsigned char* Ks = c.lds;
    LAS unsigned char* Vt = c.lds + 39168;
    const int fr = c.lane & 15, fq = c.lane >> 4;
    for (int unit = c.bid; unit < 256; unit += c.G) {
        const int g = unit & 3, nb = (unit >> 2) & 15, b = unit >> 6, tok0 = b * SEQ + nb * 128;
        __syncthreads();
        { const int j8 = c.tid & 7;
          float invf[8], kgv[8];
#pragma unroll
          for (int q = 0; q < 8; ++q) { invf[q] = __builtin_amdgcn_exp2f(-(float)(8 * (j8 & 3) + q) * (13.287712379549449f / 32.0f)) * 0.15915494309189535f; kgv[q] = kg[8 * j8 + q]; }
#pragma unroll
          for (int pass = 0; pass < 4; ++pass) { const int kr = pass * 64 + (c.tid >> 3); const bool valid = (nb > 0) || (kr >= 128);
              u32x4 kw = (u32x4){0u, 0u, 0u, 0u}; float posf = 0.f;
              if (valid) { const bf16_t* src = P + (size_t)(tok0 - 128 + kr) * ABIN + 1024 + g * 64 + 8 * j8; kw = *(const u32x4*)src; posf = (float)pos[tok0 - 128 + kr]; }
              float x[8] = {bf_lo(kw.x), bf_hi(kw.x), bf_lo(kw.y), bf_hi(kw.y), bf_lo(kw.z), bf_hi(kw.z), bf_lo(kw.w), bf_hi(kw.w)};
              float ss = 0.f;
#pragma unroll
              for (int q = 0; q < 8; ++q) ss += x[q] * x[q];
              ss += x1(ss); ss += x2(ss); ss += hm8(ss);
              const float rstd = rsqrtf(ss * (1.0f / 64.0f) + EPS);
              float y[8];
#pragma unroll
              for (int q = 0; q < 8; ++q) x[q] = x[q] * rstd * kgv[q];
#pragma unroll
              for (int q = 0; q < 8; ++q) { const float other = x4(x[q], c.lane); float rev = posf * invf[q]; rev = rev - floorf(rev);
                  const float sn = __builtin_amdgcn_sinf(rev), cs = __builtin_amdgcn_cosf(rev); y[q] = (j8 < 4) ? (x[q] * cs - other * sn) : (x[q] * cs + other * sn); }
              kw.x = cvt_pk_bf16(y[0], y[1]); kw.y = cvt_pk_bf16(y[2], y[3]); kw.z = cvt_pk_bf16(y[4], y[5]); kw.w = cvt_pk_bf16(y[6], y[7]);
              *(LAS u32x4*)(Ks + kr * 144 + 16 * j8) = kw; }
#pragma unroll
          for (int pass = 0; pass < 4; ++pass) { const int e = pass * 512 + c.tid, kr = e & 255, dg = e >> 8; const bool valid = (nb > 0) || (kr >= 128);
              u32x4 vw = (u32x4){0u, 0u, 0u, 0u};
              if (valid) vw = *(const u32x4*)(P + (size_t)(tok0 - 128 + kr) * ABIN + 1280 + g * 64 + 8 * dg);
              LAS bf16_t* vt = (LAS bf16_t*)Vt + (8 * dg) * 280 + kr;
              vt[0 * 280] = (bf16_t)(vw.x & 0xffffu); vt[1 * 280] = (bf16_t)(vw.x >> 16); vt[2 * 280] = (bf16_t)(vw.y & 0xffffu); vt[3 * 280] = (bf16_t)(vw.y >> 16);
              vt[4 * 280] = (bf16_t)(vw.z & 0xffffu); vt[5 * 280] = (bf16_t)(vw.z >> 16); vt[6 * 280] = (bf16_t)(vw.w & 0xffffu); vt[7 * 280] = (bf16_t)(vw.w >> 16); }
          if (c.tid < 144) *(LAS u32x4*)(Ks + 256 * 144 + 16 * c.tid) = (u32x4){0u, 0u, 0u, 0u};
          if (c.tid < 128) *(LAS u32x4*)(Vt + (c.tid >> 1) * 560 + 512 + 16 * (c.tid & 1)) = (u32x4){0u, 0u, 0u, 0u}; }
        const int r = c.wave >> 1, half = c.wave & 1, head = g * 4 + r;
        bf16x8 qf[4][2];
        { float invq[8], qg0[8], qg1[8];
#pragma unroll
          for (int q = 0; q < 8; ++q) { invq[q] = __builtin_amdgcn_exp2f(-(float)(8 * fq + q) * (13.287712379549449f / 32.0f)) * 0.15915494309189535f; qg0[q] = qg[8 * fq + q]; qg1[q] = qg[32 + 8 * fq + q]; }
#pragma unroll
          for (int i = 0; i < 4; ++i) { const int tokq = tok0 + 64 * half + 16 * i + fr; const bf16_t* qp = P + (size_t)tokq * ABIN + head * 64 + 8 * fq;
              const u32x4 w0 = *(const u32x4*)qp, w1 = *(const u32x4*)(qp + 32); const float posf = (float)pos[tokq];
              float x1[8] = {bf_lo(w0.x), bf_hi(w0.x), bf_lo(w0.y), bf_hi(w0.y), bf_lo(w0.z), bf_hi(w0.z), bf_lo(w0.w), bf_hi(w0.w)};
              float x2[8] = {bf_lo(w1.x), bf_hi(w1.x), bf_lo(w1.y), bf_hi(w1.y), bf_lo(w1.z), bf_hi(w1.z), bf_lo(w1.w), bf_hi(w1.w)};
              float ss = 0.f;
#pragma unroll
              for (int q = 0; q < 8; ++q) ss += x1[q] * x1[q] + x2[q] * x2[q];
              ss = sum_x16(ss); ss = sum_x32(ss);
              const float rstd = rsqrtf(ss * (1.0f / 64.0f) + EPS) * 0.125f;
              float y1[8], y2[8];
#pragma unroll
              for (int q = 0; q < 8; ++q) { const float a1 = x1[q] * rstd * qg0[q], a2 = x2[q] * rstd * qg1[q]; float rev = posf * invq[q]; rev = rev - floorf(rev);
                  const float sn = __builtin_amdgcn_sinf(rev), cs = __builtin_amdgcn_cosf(rev); y1[q] = a1 * cs - a2 * sn; y2[q] = a2 * cs + a1 * sn; }
              u32x4 o0, o1; o0.x = cvt_pk_bf16(y1[0], y1[1]); o0.y = cvt_pk_bf16(y1[2], y1[3]); o0.z = cvt_pk_bf16(y1[4], y1[5]); o0.w = cvt_pk_bf16(y1[6], y1[7]);
              o1.x = cvt_pk_bf16(y2[0], y2[1]); o1.y = cvt_pk_bf16(y2[2], y2[3]); o1.z = cvt_pk_bf16(y2[4], y2[5]); o1.w = cvt_pk_bf16(y2[6], y2[7]);
              qf[i][0] = __builtin_bit_cast(bf16x8, o0); qf[i][1] = __builtin_bit_cast(bf16x8, o1); } }
        const float sink = sinks[head];
        __syncthreads();
#pragma unroll
        for (int i = 0; i < 4; ++i) {
            const int qt = 4 * half + i, iq = 16 * qt + fr;
            f32x4 sacc[10];
#pragma unroll
            for (int t = 0; t < 10; ++t) { sacc[t] = (f32x4){0.f, 0.f, 0.f, 0.f};
#pragma unroll
                for (int s2 = 0; s2 < 2; ++s2) { const bf16x8 kf = *(const LAS bf16x8*)(Ks + (16 * (qt + t) + fr) * 144 + 64 * s2 + 16 * fq); sacc[t] = __builtin_amdgcn_mfma_f32_16x16x32_bf16(kf, qf[i][s2], sacc[t], 0, 0, 0); } }
            float m = sink;
#pragma unroll
            for (int t = 0; t < 10; ++t)
#pragma unroll
                for (int q = 0; q < 4; ++q) { const int kj = 16 * (qt + t) + 4 * fq + q; const bool vis = (kj > iq) && (kj <= iq + 128) && (nb > 0 || kj >= 128);
                    const float sv = vis ? sacc[t][q] : -1e30f; sacc[t][q] = sv; m = fmaxf(m, sv); }
            m = max_x16(m); m = max_x32(m);
            float lsum = 0.f;
#pragma unroll
            for (int t = 0; t < 10; ++t)
#pragma unroll
                for (int q = 0; q < 4; ++q) { const float pv = __expf(sacc[t][q] - m); sacc[t][q] = pv; lsum += pv; }
            lsum = sum_x16(lsum); lsum = sum_x32(lsum);
            const float inv = 1.0f / (lsum + __expf(sink - m));
            f32x4 oacc[4];
#pragma unroll
            for (int dt = 0; dt < 4; ++dt) oacc[dt] = (f32x4){0.f, 0.f, 0.f, 0.f};
#pragma unroll
            for (int u = 0; u < 5; ++u) { const bf16x8 pf = pack8(sacc[2 * u] * inv, sacc[2 * u + 1] * inv);
#pragma unroll
                for (int dt = 0; dt < 4; ++dt) { const LAS unsigned char* vp = Vt + (16 * dt + fr) * 560 + (16 * (qt + 2 * u) + 4 * fq) * 2;
                    const u32x2 v0 = *(const LAS u32x2*)vp, v1 = *(const LAS u32x2*)(vp + 32); const u32x4 vv = (u32x4){v0.x, v0.y, v1.x, v1.y};
                    oacc[dt] = __builtin_amdgcn_mfma_f32_16x16x32_bf16(__builtin_bit_cast(bf16x8, vv), pf, oacc[dt], 0, 0, 0); } }
#pragma unroll
            for (int dt = 0; dt < 4; ++dt) { u32x2 w; w.x = cvt_pk_bf16(oacc[dt][0], oacc[dt][1]); w.y = cvt_pk_bf16(oacc[dt][2], oacc[dt][3]); *(u32x2*)(MIX + (size_t)(tok0 + 16 * qt + fr) * D + head * 64 + 16 * dt + 4 * fq) = w; }
        }
    }
}
__device__ __forceinline__ void gating_mfma(const Ctx& c, int li) {
    const bf16_t* P = (const bf16_t*)(c.ws + WS_PROJ); bf16_t* MIX = (bf16_t*)(c.ws + WS_MIX);
    const float* wsp = (const float*)in_ptr(c, I_GMWS) + (size_t)li * 8 * 128 * 128; const float* bsp = (const float*)in_ptr(c, I_GMB) + li * 8 * 128;
    LAS unsigned char* Wl = c.lds;
    LAS unsigned char* Vn = c.lds + 34816;
    LAS unsigned char* MR = c.lds + 69632;
    const float* STATS = (const float*)(c.ws + WS_STATS); const float* vng = (const float*)in_ptr(c, I_VNG) + li * 1024;
    const int fr = c.lane & 15, fq = c.lane >> 4;
    int wgrp = -1;
    for (int unit = c.bid; unit < 512; unit += c.G) {
        const int grp = unit & 7, nc = (unit >> 3) & 15, b = unit >> 7, tok0 = b * SEQ + nc * 128;
        __syncthreads();
        if (grp != wgrp) { wgrp = grp;
#pragma unroll
        for (int pass = 0; pass < 8; ++pass) { const int e = pass * 512 + c.tid, t = e >> 5, s4 = (e & 31) * 4;
            const f32x4 w = *(const f32x4*)(wsp + ((size_t)grp * 128 + t) * 128 + s4);
            u32x2 o; o.x = cvt_pk_bf16(s4 + 0 <= t ? w[0] : 0.f, s4 + 1 <= t ? w[1] : 0.f); o.y = cvt_pk_bf16(s4 + 2 <= t ? w[2] : 0.f, s4 + 3 <= t ? w[3] : 0.f);
            *(LAS u32x2*)(Wl + t * 272 + s4 * 2) = o; } }
        if (c.tid < 128) { const f32x4* sp = (const f32x4*)(STATS + (size_t)(tok0 + c.tid) * 32); float s1 = 0.f, s2 = 0.f;
#pragma unroll
            for (int i = 0; i < 8; ++i) { const f32x4 w = sp[i]; s1 += w[0] + w[2]; s2 += w[1] + w[3]; }
            const float mean = s1 * (1.0f / 1024.0f), var = fmaxf(s2 * (1.0f / 1024.0f) - mean * mean, 0.f);
            *(LAS f32x2*)(MR + 8 * c.tid) = (f32x2){mean, rsqrtf(var + EPS)}; }
        __syncthreads();
#pragma unroll
        for (int pass = 0; pass < 4; ++pass) { const int e = pass * 512 + c.tid, sidx = e & 127, d0 = (e >> 7) * 8;
            const u32x4 vw = *(const u32x4*)(P + (size_t)(tok0 + sidx) * ABIN + 2560 + grp * 128 + d0);
            const f32x2 mr = *(const LAS f32x2*)(MR + 8 * sidx); const f32x4 g0 = *(const f32x4*)(vng + grp * 128 + d0), g1 = *(const f32x4*)(vng + grp * 128 + d0 + 4);
            LAS bf16_t* vt = (LAS bf16_t*)Vn + d0 * 136 + sidx;
            vt[0 * 136] = f2bf((bf_lo(vw.x) - mr.x) * mr.y * g0[0]); vt[1 * 136] = f2bf((bf_hi(vw.x) - mr.x) * mr.y * g0[1]); vt[2 * 136] = f2bf((bf_lo(vw.y) - mr.x) * mr.y * g0[2]); vt[3 * 136] = f2bf((bf_hi(vw.y) - mr.x) * mr.y * g0[3]);
            vt[4 * 136] = f2bf((bf_lo(vw.z) - mr.x) * mr.y * g1[0]); vt[5 * 136] = f2bf((bf_hi(vw.z) - mr.x) * mr.y * g1[1]); vt[6 * 136] = f2bf((bf_lo(vw.w) - mr.x) * mr.y * g1[2]); vt[7 * 136] = f2bf((bf_hi(vw.w) - mr.x) * mr.y * g1[3]); }
        __syncthreads();
        f32x4 acc[8];
#pragma unroll
        for (int dt = 0; dt < 8; ++dt) acc[dt] = (f32x4){0.f, 0.f, 0.f, 0.f};
        const int nks = (c.wave >> 1) + 1;
        for (int ks = 0; ks < nks; ++ks) {
            const bf16x8 wf = *(const LAS bf16x8*)(Wl + (16 * c.wave + fr) * 272 + 64 * ks + 16 * fq);
#pragma unroll
            for (int dt = 0; dt < 8; ++dt) { const bf16x8 vf = *(const LAS bf16x8*)(Vn + (16 * dt + fr) * 272 + 64 * ks + 16 * fq); acc[dt] = __builtin_amdgcn_mfma_f32_16x16x32_bf16(vf, wf, acc[dt], 0, 0, 0); }
        }
        { const int t = 16 * c.wave + fr; const float bias = bsp[grp * 128 + t]; const size_t tok = (size_t)(tok0 + t);
#pragma unroll
          for (int dt = 0; dt < 8; ++dt) { const int d = 16 * dt + 4 * fq; const u32x2 uw = *(const u32x2*)(P + tok * ABIN + 1536 + grp * 128 + d);
              u32x2 w; w.x = cvt_pk_bf16(bf_lo(uw.x) * (acc[dt][0] + bias), bf_hi(uw.x) * (acc[dt][1] + bias)); w.y = cvt_pk_bf16(bf_lo(uw.y) * (acc[dt][2] + bias), bf_hi(uw.y) * (acc[dt][3] + bias));
              *(u32x2*)(MIX + tok * D + 1024 + grp * 128 + d) = w; } }
    }
}

typedef short s16x4 __attribute__((ext_vector_type(4)));
__device__ __forceinline__ unsigned vimg_off(unsigned t, unsigned ch) { return 256u * t + 16u * (ch ^ (((t & 3u) << 2) | ((t >> 2) & 3u))); }
__device__ __forceinline__ s16x4 vtr4(LAS unsigned char* img, int rb, int cb, int lane) {
    const unsigned q = ((unsigned)lane & 15u) >> 2, pp = (unsigned)lane & 3u;
    return __builtin_amdgcn_ds_read_tr16_b64_v4i16((LAS s16x4*)(img + vimg_off((unsigned)rb + q, 2u * (unsigned)cb + (pp >> 1)) + 8u * (pp & 1u)));
}
__device__ __forceinline__ bf16x8 cat8(s16x4 a, s16x4 b) { return (bf16x8){a[0], a[1], a[2], a[3], b[0], b[1], b[2], b[3]}; }
namespace hg2 { constexpr int QD = 0, QE = 17408, KD = 34816, KDT = 52224, VT = 70656, SBT = 89088, PART = 123904, EL = 132096, ED = 132608, SSQ = 133120; }
__device__ __forceinline__ f32x4 exp4(f32x4 x) { f32x4 r; r[0] = __expf(x[0]); r[1] = __expf(x[1]); r[2] = __expf(x[2]); r[3] = __expf(x[3]); return r; }
template <bool FULL>
__device__ __forceinline__ void hgrn_seg(const Ctx& c, int lj) {
    using namespace hg2;
    const bf16_t* P = (const bf16_t*)(c.ws + WS_PROJ); const float* LOGF = (const float*)(c.ws + WS_LOGF); bf16_t* MIX = (bf16_t*)(c.ws + WS_MIX);
    f32x4* HGL = (f32x4*)(c.ws + WS_HGL); float* HGD = (float*)(c.ws + WS_HGD);
    const float* gain = (const float*)in_ptr(c, I_CONG) + lj * 128;
    LAS unsigned char* L = c.lds;
    const int fr = c.lane & 15, fq = c.lane >> 4, k4 = c.tid & 31, tg = c.tid >> 5;
    const int tt = c.wave >> 1, vt0 = 4 * (c.wave & 1);
    const int vrow = c.tid >> 4, vch = c.tid & 15;
    const unsigned olf = (unsigned)(4 * tg) * 8192u + 16u * (unsigned)k4, oq = (unsigned)(4 * tg) * (CIN * 2u) + 8u * (unsigned)k4, ov = (unsigned)vrow * (CIN * 2u) + 16u * (unsigned)vch;
    const unsigned og = (unsigned)(16 * tt + fr) * (CIN * 2u) + (unsigned)(16 * vt0 + 4 * fq) * 2u, oo = (unsigned)(16 * tt + fr) * (D * 2u) + (unsigned)(16 * vt0 + 4 * fq) * 2u;
    for (int unit = c.bid; unit < 256; unit += c.G) {
        const int seg = unit & 3, bh = unit >> 2, b = bh >> 4, h = bh & 15;
        if (!FULL && seg == 3) continue;
        f32x4 S[8];
#pragma unroll
        for (int j = 0; j < 8; ++j) S[j] = (f32x4){0.f, 0.f, 0.f, 0.f};
        if (FULL) {
            for (int sp = 0; sp < seg; ++sp) { const f32x4 dv = *(const f32x4*)(HGD + (size_t)(bh * 3 + sp) * 128 + 16 * c.wave + 4 * fq); const f32x4* lp = HGL + ((size_t)((bh * 3 + sp) * 8 + c.wave) * 8) * 64 + c.lane;
#pragma unroll
                for (int j = 0; j < 8; ++j) S[j] = dv * S[j] + lp[j * 64]; }
        }
        __syncthreads();
        if (FULL) {
#pragma unroll
            for (int j = 0; j < 8; ++j) { u32x2 w; w.x = cvt_pk_bf16(S[j][0], S[j][1]); w.y = cvt_pk_bf16(S[j][2], S[j][3]); *(LAS u32x2*)(L + SBT + (16 * j + fr) * 272 + (16 * c.wave + 4 * fq) * 2) = w; }
        }
        f32x4 dsum = (f32x4){0.f, 0.f, 0.f, 0.f};
        const size_t tokb = (size_t)b * SEQ + seg * 512;
        f32x4 lf[4]; u32x2 qw[4]; u32x4 vw[2];
        { const char* blf = (const char*)(LOGF + tokb * 2048 + h * 128); const char* bq = (const char*)(P + tokb * CIN + h * 128);
#pragma unroll
          for (int r = 0; r < 4; ++r) { lf[r] = *(const f32x4*)(blf + olf + r * 8192u); if (FULL) qw[r] = *(const u32x2*)(bq + oq + r * (CIN * 2u)); }
#pragma unroll
          for (int i = 0; i < 2; ++i) vw[i] = *(const u32x4*)(bq + 8192 + ov + i * (32u * CIN * 2u)); }
        u32x2 ypk[4];
        for (int ch = 0; ch < 8; ++ch) {
            const size_t tokc = tokb + ch * 64;
            u32x2 gtw[4];
            if (FULL) {
#pragma unroll
                for (int j = 0; j < 4; ++j) gtw[j] = *(const u32x2*)((const char*)(P + tokc * CIN + 6144 + h * 128) + og + 32u * j); }
            f32x4 bc[4];
            { f32x4 run = (f32x4){0.f, 0.f, 0.f, 0.f};
#pragma unroll
              for (int r = 0; r < 4; ++r) { run += lf[r]; bc[r] = run; }
              *(LAS f32x4*)(L + PART + (tg * 128 + 4 * k4) * 4) = run; }
            __syncthreads();
            if (FULL && ch > 0) {
#pragma unroll
                for (int j = 0; j < 4; ++j) *(u32x2*)((char*)(MIX + (tokc - 64) * D + h * 128) + oo + 32u * j) = ypk[j]; }
            { f32x4 base = (f32x4){0.f, 0.f, 0.f, 0.f}, bmid = base, blast = base;
#pragma unroll
              for (int g = 0; g < 16; ++g) { const f32x4 pv = *(const LAS f32x4*)(L + PART + (g * 128 + 4 * k4) * 4); if (g < tg) base += pv; if (g < 8) bmid += pv; blast += pv; }
              if (tg == 0) { *(LAS f32x4*)(L + EL + 16 * k4) = exp4(blast - bmid); *(LAS f32x4*)(L + ED + 16 * k4) = exp4(blast); if (!FULL) dsum += blast; }
              f32x4 emid; if (FULL) emid = exp4(bmid);
              f32x4 kdr[4];
#pragma unroll
              for (int r = 0; r < 4; ++r) { const f32x4 bb = base + bc[r]; const f32x4 e2 = exp4(bmid - bb); const f32x4 kd = (1.0f - exp4(lf[r])) * e2; kdr[r] = kd; const int t = 4 * tg + r;
                  u32x2 w; w.x = cvt_pk_bf16(kd[0], kd[1]); w.y = cvt_pk_bf16(kd[2], kd[3]); *(LAS u32x2*)(L + KD + t * 272 + 8 * k4) = w;
                  if (FULL) { const f32x4 e1 = exp4(bb - bmid); const f32x4 qf = (f32x4){bf_lo(qw[r].x), bf_hi(qw[r].x), bf_lo(qw[r].y), bf_hi(qw[r].y)}; const f32x4 qd = qf * e1, qe = qd * emid;
                      u32x2 a; a.x = cvt_pk_bf16(qd[0], qd[1]); a.y = cvt_pk_bf16(qd[2], qd[3]); *(LAS u32x2*)(L + QD + t * 272 + 8 * k4) = a;
                      u32x2 e; e.x = cvt_pk_bf16(qe[0], qe[1]); e.y = cvt_pk_bf16(qe[2], qe[3]); *(LAS u32x2*)(L + QE + t * 272 + 8 * k4) = e; } }
#pragma unroll
              for (int q = 0; q < 4; ++q) { u32x2 w; w.x = cvt_pk_bf16(kdr[0][q], kdr[1][q]); w.y = cvt_pk_bf16(kdr[2][q], kdr[3][q]); *(LAS u32x2*)(L + KDT + (4 * k4 + q) * 144 + 8 * tg) = w; }
#pragma unroll
              for (int i = 0; i < 2; ++i) *(LAS u32x4*)(L + VT + vimg_off((unsigned)(vrow + 32 * i), (unsigned)vch)) = vw[i]; }
            __syncthreads();
            if (ch + 1 < 8) { const size_t tn = tokc + 64; const char* blf = (const char*)(LOGF + tn * 2048 + h * 128); const char* bq = (const char*)(P + tn * CIN + h * 128);
#pragma unroll
                for (int r = 0; r < 4; ++r) { lf[r] = *(const f32x4*)(blf + olf + r * 8192u); if (FULL) qw[r] = *(const u32x2*)(bq + oq + r * (CIN * 2u)); }
#pragma unroll
                for (int i = 0; i < 2; ++i) vw[i] = *(const u32x4*)(bq + 8192 + ov + i * (32u * CIN * 2u)); }
            { f32x4 U[8];
#pragma unroll
              for (int j = 0; j < 8; ++j) U[j] = (f32x4){0.f, 0.f, 0.f, 0.f};
#pragma unroll
              for (int ks = 0; ks < 2; ++ks) { bf16x8 bfv[8];
                  const bf16x8 af = *(const LAS bf16x8*)(L + KDT + (16 * c.wave + fr) * 144 + 64 * ks + 16 * fq);
#pragma unroll
                  for (int j = 0; j < 8; ++j) bfv[j] = cat8(vtr4(L + VT, 32 * ks + 8 * fq, j, c.lane), vtr4(L + VT, 32 * ks + 8 * fq + 4, j, c.lane));
#pragma unroll
                  for (int j = 0; j < 8; ++j) U[j] = __builtin_amdgcn_mfma_f32_16x16x32_bf16(af, bfv[j], U[j], 0, 0, 0); }
              const f32x4 ed = *(const LAS f32x4*)(L + ED + (16 * c.wave + 4 * fq) * 4), el = *(const LAS f32x4*)(L + EL + (16 * c.wave + 4 * fq) * 4);
#pragma unroll
              for (int j = 0; j < 8; ++j) S[j] = ed * S[j] + el * U[j]; }
            f32x4 o[4];
            if (FULL) {
                f32x4 sc[4];
                { bf16x8 qdf[4];
#pragma unroll
                  for (int ks = 0; ks < 4; ++ks) qdf[ks] = *(const LAS bf16x8*)(L + QD + (16 * tt + fr) * 272 + 64 * ks + 16 * fq);
#pragma unroll
                  for (int st = 0; st < 4; ++st) { sc[st] = (f32x4){0.f, 0.f, 0.f, 0.f};
                    if (st <= tt) { bf16x8 kdf[4];
#pragma unroll
                        for (int ks = 0; ks < 4; ++ks) kdf[ks] = *(const LAS bf16x8*)(L + KD + (16 * st + fr) * 272 + 64 * ks + 16 * fq);
#pragma unroll
                        for (int ks = 0; ks < 4; ++ks) sc[st] = __builtin_amdgcn_mfma_f32_16x16x32_bf16(kdf[ks], qdf[ks], sc[st], 0, 0, 0);
                        if (st == tt) {
#pragma unroll
                            for (int q = 0; q < 4; ++q) sc[st][q] = (4 * fq + q <= fr) ? sc[st][q] : 0.f; } } } }
                const bf16x8 pf0 = pack8(sc[0], sc[1]), pf1 = pack8(sc[2], sc[3]);
#pragma unroll
                for (int j = 0; j < 4; ++j) o[j] = (f32x4){0.f, 0.f, 0.f, 0.f};
#pragma unroll
                for (int ks = 0; ks < 4; ++ks) { bf16x8 sbf[4]; const bf16x8 qef = *(const LAS bf16x8*)(L + QE + (16 * tt + fr) * 272 + 64 * ks + 16 * fq);
#pragma unroll
                    for (int j = 0; j < 4; ++j) sbf[j] = *(const LAS bf16x8*)(L + SBT + (16 * (vt0 + j) + fr) * 272 + 64 * ks + 16 * fq);
                    __builtin_amdgcn_sched_barrier(0);
#pragma unroll
                    for (int j = 0; j < 4; ++j) o[j] = __builtin_amdgcn_mfma_f32_16x16x32_bf16(sbf[j], qef, o[j], 0, 0, 0);
                    __builtin_amdgcn_sched_barrier(0); }
#pragma unroll
                for (int u = 0; u < 2; ++u) { if (2 * u <= tt) { bf16x8 vf[4];
#pragma unroll
                    for (int j = 0; j < 4; ++j) vf[j] = cat8(vtr4(L + VT, 32 * u + 4 * fq, vt0 + j, c.lane), vtr4(L + VT, 32 * u + 16 + 4 * fq, vt0 + j, c.lane));
#pragma unroll
                    for (int j = 0; j < 4; ++j) o[j] = __builtin_amdgcn_mfma_f32_16x16x32_bf16(vf[j], u == 0 ? pf0 : pf1, o[j], 0, 0, 0); } }
            }
            if (FULL) {
                { f32x4 sq = (f32x4){0.f, 0.f, 0.f, 0.f};
#pragma unroll
                  for (int j = 0; j < 4; ++j) sq += o[j] * o[j];
                  float x = (sq[0] + sq[1]) + (sq[2] + sq[3]); x = sum_x16(x); x = sum_x32(x);
                  if (fq == 0) ((LAS float*)(L + SSQ))[c.wave * 16 + fr] = x; }
                __syncthreads();
#pragma unroll
                for (int j = 0; j < 8; ++j) { u32x2 w; w.x = cvt_pk_bf16(S[j][0], S[j][1]); w.y = cvt_pk_bf16(S[j][2], S[j][3]); *(LAS u32x2*)(L + SBT + (16 * j + fr) * 272 + (16 * c.wave + 4 * fq) * 2) = w; }
                const float rstd = rsqrtf((((const LAS float*)(L + SSQ))[c.wave * 16 + fr] + ((const LAS float*)(L + SSQ))[(c.wave ^ 1) * 16 + fr]) * (1.0f / 128.0f) + EPS);
#pragma unroll
                for (int j = 0; j < 4; ++j) { const f32x4 gn = *(const f32x4*)(gain + 16 * (vt0 + j) + 4 * fq); const f32x4 gt = (f32x4){bf_lo(gtw[j].x), bf_hi(gtw[j].x), bf_lo(gtw[j].y), bf_hi(gtw[j].y)};
                    const f32x4 y = o[j] * rstd * gn * gt; ypk[j].x = cvt_pk_bf16(y[0], y[1]); ypk[j].y = cvt_pk_bf16(y[2], y[3]); }
            }
        }
        if (FULL) {
#pragma unroll
            for (int j = 0; j < 4; ++j) *(u32x2*)((char*)(MIX + (tokb + 7 * 64) * D + h * 128) + oo + 32u * j) = ypk[j]; }
        if (!FULL) {
            f32x4* lp = HGL + ((size_t)((bh * 3 + seg) * 8 + c.wave) * 8) * 64 + c.lane;
#pragma unroll
            for (int j = 0; j < 8; ++j) lp[j * 64] = S[j];
            if (tg == 0) *(f32x4*)(HGD + (size_t)(bh * 3 + seg) * 128 + 4 * k4) = exp4(dsum);
        }
    }
}

constexpr int PH_PER_LAYER = 9, PH_FINAL = 1 + DEPTH * PH_PER_LAYER, N_PHASES = PH_FINAL + 1;
template <int KIND, bool DRY = false>
__device__ __forceinline__ void run_phase(const Ctx& c0, int l) {
    Ctx c = c0; { unsigned long long w = (unsigned long long)c.ws; asm volatile("" : "+s"(w)); c.ws = (unsigned char*)w; int t = c.wave * 64 + my_lane(); asm volatile("" : "+v"(t)); c.tid = t; c.lane = t & 63; }
    const int li = l >> 1; const bool odd = (l & 1) != 0;
    const int vcu = (c.G % 8 == 0) ? (c.bid % 8) * (c.G / 8) + c.bid / 8 : c.bid;
    if constexpr (KIND == 0) { p0_ada(c); __syncthreads(); p0_convert(c); p0_lb(c); }
    if constexpr (KIND == 1) norm_phase<0, DRY>(c, l);
    if constexpr (KIND == 2) { pg8::Gemm g{(const bf16_t*)(c.ws + WS_H), (const bf16_t*)(c.ws + WS_WABIN) + (size_t)li * ABIN * D, T, ABIN, D}; pg8::StaticOrder S; S.init(T, ABIN, c.G, c.bid);
        pg8::EpiProjA E{(bf16_t*)(c.ws + WS_PROJ), (float*)(c.ws + WS_STATS)}; pg8::gemm_phase<pg8::EpiProjA, pg8::StaticOrder>(c.lds, g, S, E, c.tid); }
    if constexpr (KIND == 3) { pg8::Gemm g{(const bf16_t*)(c.ws + WS_H), (const bf16_t*)(c.ws + WS_WCIN) + (size_t)li * CIN * D, T, CIN, D}; pg8::StaticOrder S; S.init(T, CIN, c.G, c.bid);
        pg8::EpiProjC E{(bf16_t*)(c.ws + WS_PROJ), (float*)(c.ws + WS_LOGF), (const float*)(c.ws + WS_LB) + l * D}; pg8::gemm_phase<pg8::EpiProjC, pg8::StaticOrder>(c.lds, g, S, E, c.tid); }
    if constexpr (KIND == 5) { attn_mfma(c, li); gating_mfma(c, li); }
    if constexpr (KIND == 6) hgrn_seg<true>(c, li);
    if constexpr (KIND == 13) hgrn_seg<false>(c, li);
    if constexpr (KIND == 7) {
        const bf16_t* Bt = odd ? (const bf16_t*)(c.ws + WS_WCOUT) + (size_t)li * D * D : (const bf16_t*)(c.ws + WS_WABOUT) + (size_t)li * D * D;
        pg8::Gemm g{(const bf16_t*)(c.ws + WS_MIX), Bt, T, D, D}; pg8::StaticOrder S; S.init(T, D, c.G, c.bid);
        float* xr = (l == 0) ? (float*)in_ptr(c, I_X) : (float*)in_ptr(c, 24);
        pg8::EpiResid E{xr, (const float*)(c.ws + WS_MOD) + (size_t)l * 4 * 12288 + 2 * D, (long)((DRY ? (float*)(c.ws + WS_PROJ) : (float*)in_ptr(c, 24)) - xr)}; pg8::gemm_phase<pg8::EpiResid, pg8::StaticOrder>(c.lds, g, S, E, c.tid); }
    if constexpr (KIND == 8) norm_phase<1, DRY>(c, l);
    if constexpr (KIND == 10) { LAS int* pb = (LAS int*)(c.lds + MISC_OFF) + 16; moe_tables(c, l, pb);
        pg8::Gemm g{(const bf16_t*)(c.ws + WS_H), (const bf16_t*)(c.ws + WS_WGU), 0, 0, D}; pg8::MoeOrder S{pb, 4, c.G, vcu, l * 16 * 4, 128, 0, (const int*)(c.ws + WS_LIST)};
        pg8::EpiMoe1 E{(bf16_t*)(c.ws + WS_HID), (const float*)(c.ws + WS_GW)}; pg8::gemm_phase<pg8::EpiMoe1, pg8::MoeOrder, true, true, true>(c.lds, g, S, E, c.tid); if (l + 1 < DEPTH) { const int U = pb[16] * 4, rounds = (U + c.G - 1) / c.G, busy = U - (rounds - 1) * c.G; __syncthreads(); moe_conv_tail(c, l + 1, 0, vcu >= busy ? vcu - busy : -1, c.G - busy > 0 ? c.G - busy : 1); if (busy >= c.G) moe_conv_tail(c, l + 1, 0, vcu, c.G); } }
    if constexpr (KIND == 11) { LAS int* pb = (LAS int*)(c.lds + MISC_OFF) + 16; moe_tables(c, l, pb);
        pg8::Gemm g{(const bf16_t*)(c.ws + WS_HID), (const bf16_t*)(c.ws + WS_WDN), 0, 0, DE}; pg8::MoeOrder S{pb, 8, c.G, vcu, l * 16 * 8, 256, 0, nullptr};
        pg8::EpiMoe2 E{(bf16_t*)(c.ws + WS_Y)}; pg8::gemm_phase<pg8::EpiMoe2, pg8::MoeOrder>(c.lds, g, S, E, c.tid); if (l + 1 < DEPTH) { const int U = pb[16] * 8, rounds = (U + c.G - 1) / c.G, busy = U - (rounds - 1) * c.G; __syncthreads(); moe_conv_tail(c, l + 1, 1, vcu >= busy ? vcu - busy : -1, c.G - busy > 0 ? c.G - busy : 1); if (busy >= c.G) moe_conv_tail(c, l + 1, 1, vcu, c.G); } }
    if constexpr (KIND == 12) norm_phase<2, DRY>(c, 0);
}
__device__ __forceinline__ Ctx make_ctx(const Args& a, unsigned char* lds_raw) {
    Ctx c; c.lds = (LAS unsigned char*)lds_raw; c.tid = threadIdx.x; c.lane = c.tid & 63; c.wave = __builtin_amdgcn_readfirstlane(c.tid >> 6); c.G = gridDim.x; c.bid = blockIdx.x; c.ws = a.ws;
    if (c.tid < 25) ((LAS unsigned long long*)(c.lds + INP_OFF))[c.tid] = (c.tid < 24) ? (unsigned long long)a.in[c.tid] : (unsigned long long)a.out;
    __syncthreads();
    return c;
}
__global__ void __launch_bounds__(512, 2) mega(Args a) {
    extern __shared__ __attribute__((aligned(16))) unsigned char lds_raw[];
    const Ctx c = make_ctx(a, lds_raw);
    volatile LAS unsigned* MISC = (volatile LAS unsigned*)(c.lds + MISC_OFF);
    if (c.tid < 16) MISC[c.tid] = 0u;
    __syncthreads();
    XcdBarrier bar = xcd_barrier_post((unsigned*)(c.ws + WS_CTL) + CW_BAR, MISC + 8, c.wave);
#define RP(k, l) do { run_phase<k>(c, l); xcd_barrier(bar, c.wave); if ((PROBE_DUP >> k) & 1) { run_phase<k, true>(c, l); xcd_barrier(bar, c.wave); } } while (0)
    RP(0, 0);
#define LAYER_EVEN(l) do { RP(1, l); RP(2, l); RP(5, l); RP(7, l); RP(8, l); RP(10, l); RP(11, l); } while (0)
#define LAYER_ODD(l) do { RP(1, l); RP(3, l); RP(13, l); RP(6, l); RP(7, l); RP(8, l); RP(10, l); RP(11, l); } while (0)
    LAYER_EVEN(0); LAYER_ODD(1); LAYER_EVEN(2); LAYER_ODD(3);
    run_phase<12>(c, 0);
    if ((PROBE_DUP >> 12) & 1) { xcd_barrier(bar, c.wave); run_phase<12, true>(c, 0); }
}

extern "C" void kernel_launch(void* const* d_in, const int* in_sizes, int n_in, void* d_out, int out_size, void* d_ws, size_t ws_size, hipStream_t stream) {
    static int grid = 0;
    if (grid == 0) {
        if (n_in != 24 || out_size != T * D || ws_size < WS_END) { fprintf(stderr, "kernel_launch: unexpected shapes: n_in %d out %d ws %zu (need %zu)\n", n_in, out_size, ws_size, (size_t)WS_END); grid = -1; return; }
        int dev = 0, cus = 0;
        if (hipGetDevice(&dev) != hipSuccess || hipDeviceGetAttribute(&cus, hipDeviceAttributeMultiprocessorCount, dev) != hipSuccess) { grid = -1; return; }
        int per_cu = 0;
        if (hipFuncSetAttribute((const void*)mega, hipFuncAttributeMaxDynamicSharedMemorySize, LDS_BYTES) != hipSuccess) { fprintf(stderr, "kernel_launch: hipFuncSetAttribute failed\n"); grid = -1; return; }
        if (hipOccupancyMaxActiveBlocksPerMultiprocessor(&per_cu, (const void*)mega, 512, LDS_BYTES) != hipSuccess || per_cu < 1) fprintf(stderr, "kernel_launch: occupancy query reports %d\n", per_cu);
        (void)hipGetLastError();
        grid = cus;
    }
    if (grid < 0) return;
    (void)hipMemsetAsync((char*)d_ws + WS_CTL, 0, CTL_ZERO_BYTES, stream);
    Args a{};
    for (int i = 0; i < 24; ++i) a.in[i] = d_in[i];
    a.out = (float*)d_out; a.ws = (unsigned char*)d_ws;
    hipLaunchKernelGGL(mega, dim3(grid), dim3(512), LDS_BYTES, stream, a);
}
```
